# Optimizing an MI355X kernel written in HIP

```python
import math
import jax, jax.numpy as jnp
from jax import lax
import numpy as np


D_MODEL = 1024
BATCH = 8
SEQ = 2048
DEPTH = 2
DEC_BATCH = 128
DEC_SEQ = 4
PAST_LEN = 16384
PAGE_SIZE = 128

N_META = 16
D_POOL = D_MODEL // 2
POOL_WINDOWS = (2, 4, 8, 16)
N_POOL_GROUPS = len(POOL_WINDOWS)
POOL_GROUP = D_POOL // N_POOL_GROUPS
POOL_BUF = max(POOL_WINDOWS) - 1
D_GLA = D_MODEL - D_POOL
GLA_HEADS = 4
GLA_DV = D_GLA // GLA_HEADS
GLA_DK = GLA_DV // 2
D_GLA_K = GLA_HEADS * GLA_DK
GATE_RANK = 16
GATE_TAU = 16.0
GLA_CHUNK = 64
D_FF = 2816
CONV_W = 3
CONV_BUF = CONV_W - 1
SPLIT_SIZES = (D_POOL, D_GLA_K, D_GLA_K, D_GLA, D_GLA, GATE_RANK)
D_IN = sum(SPLIT_SIZES)
SPLIT_IDX = tuple(int(i) for i in np.cumsum(SPLIT_SIZES)[:-1])
ALPHA = (2 * DEPTH) ** 0.25
BETA = (8 * DEPTH) ** -0.25
LN_EPS = 1e-5
RMS_EPS = 1e-6

kernel_name = "hybrid_pool_gla_convffn_step"


def layer_norm(x, g, b):
    xf = x.astype(jnp.float32)
    mu = jnp.mean(xf, -1, keepdims=True)
    var = jnp.mean(jnp.square(xf - mu), -1, keepdims=True)
    return ((xf - mu) * lax.rsqrt(var + LN_EPS)).astype(x.dtype) * g + b


def multiscale_pool(u, prev, pos0, w_pool, pool_scale):
    B, L, _ = u.shape
    P = prev.shape[1]
    full = jnp.concatenate([prev, u], 1).astype(jnp.float32)
    cs = jnp.cumsum(full, axis=1)
    cs = jnp.concatenate([jnp.zeros_like(cs[:, :1]), cs], 1)
    idx = P + jnp.arange(L)
    pos = pos0 + jnp.arange(L)
    means = []
    for g, w in enumerate(POOL_WINDOWS):
        c = cs[..., g * POOL_GROUP:(g + 1) * POOL_GROUP]
        lo = jnp.maximum(idx + 1 - w, 0)
        cnt = jnp.minimum(w, pos + 1).astype(jnp.float32)
        means.append((c[:, idx + 1] - c[:, lo]) / cnt[None, :, None])
    d = jnp.concatenate(means, -1) - u.astype(jnp.float32)
    d = d.reshape(B, L, N_POOL_GROUPS, POOL_GROUP)
    y = jnp.einsum('blgc,gcd->blgd', d, w_pool.astype(jnp.float32)).reshape(B, L, D_POOL)
    return (y * pool_scale.astype(jnp.float32)).astype(u.dtype), full[:, -POOL_BUF:].astype(u.dtype)


def gla_chunk(S, q, k, v, loga):
    C = q.shape[1]
    b = jnp.cumsum(loga, axis=1)
    causal = jnp.tril(jnp.ones((C, C), bool))
    rel = b[:, :, None] - b[:, None, :]
    decay = jnp.exp(jnp.where(causal[None, :, :, None, None], rel, -jnp.inf))
    attn = jnp.einsum('bthd,bshd,btshd->bhts', q, k, decay)
    o = jnp.einsum('bhts,bshv->bthv', attn, v) + jnp.einsum('bthd,bhdv->bthv', q * jnp.exp(b), S)
    b_end = b[:, -1]
    k_dec = k * jnp.exp(b_end[:, None] - b)
    S_new = jnp.exp(b_end)[..., None] * S + jnp.einsum('bshd,bshv->bhdv', k_dec, v)
    return S_new, o


def gla_prompt(S0, q, k, v, loga):
    B = q.shape[0]
    S1, o_meta = gla_chunk(S0, q[:, :N_META], k[:, :N_META], v[:, :N_META], loga[:, :N_META])

    def to_chunks(t):
        t = t[:, N_META:]
        return t.reshape(B, -1, GLA_CHUNK, *t.shape[2:]).swapaxes(0, 1)

    S_fin, o_rest = lax.scan(lambda S, xs: gla_chunk(S, *xs), S1,
                             (to_chunks(q), to_chunks(k), to_chunks(v), to_chunks(loga)))
    o_rest = o_rest.swapaxes(0, 1).reshape(B, -1, GLA_HEADS, GLA_DV)
    return S_fin, jnp.concatenate([o_meta, o_rest], 1)


def causal_dwconv(gt, prev, conv_w, conv_b):
    L = gt.shape[1]
    full = jnp.concatenate([prev, gt], 1)
    y = conv_b + conv_w[0] * full[:, 0:L] + conv_w[1] * full[:, 1:L + 1] + conv_w[2] * full[:, 2:L + 2]
    return y, full[:, -CONV_BUF:]


def trunk_layer(x, pool_prev, gla_S0, conv_prev, pos0, is_prompt,
                w_in, w_a2, b_a, w_pool, pool_scale, gla_norm, w_out, ln1_g, ln1_b,
                w_up, w_gate, conv_w, conv_b, w_down, ln2_g, ln2_b):
    B, L, _ = x.shape
    h = x @ w_in
    u_pool, q, k, v, r, zr = jnp.split(h, SPLIT_IDX, axis=-1)
    y_pool, pool_buf = multiscale_pool(u_pool, pool_prev, pos0, w_pool, pool_scale)
    f32 = jnp.float32
    loga = jax.nn.log_sigmoid((zr @ w_a2 + b_a).astype(f32)) / GATE_TAU
    qh = (q.astype(f32) * GLA_DK ** -0.5).reshape(B, L, GLA_HEADS, GLA_DK)
    kh = k.astype(f32).reshape(B, L, GLA_HEADS, GLA_DK)
    vh = v.astype(f32).reshape(B, L, GLA_HEADS, GLA_DV)
    lh = loga.reshape(B, L, GLA_HEADS, GLA_DK)
    S0 = gla_S0.astype(f32)
    if is_prompt:
        S_new, o = gla_prompt(S0, qh, kh, vh, lh)
    else:
        S_new, o = gla_chunk(S0, qh, kh, vh, lh)
    o = o * lax.rsqrt(jnp.mean(jnp.square(o), -1, keepdims=True) + RMS_EPS) * gla_norm.astype(f32)
    y_gla = (o.reshape(B, L, D_GLA) * jax.nn.silu(r.astype(f32))).astype(x.dtype)
    mix = jnp.concatenate([y_pool, y_gla], -1) @ w_out
    x = layer_norm(ALPHA * x + mix, ln1_g, ln1_b)
    a = x @ w_up
    gt = x @ w_gate
    gc, conv_buf = causal_dwconv(gt, conv_prev, conv_w, conv_b)
    f = (a * jax.nn.silu(gc)) @ w_down
    x = layer_norm(ALPHA * x + f, ln2_g, ln2_b)
    return x, pool_buf, S_new.astype(gla_S0.dtype), conv_buf


def setup_inputs(seed: int = 0) -> dict:
    key = jax.random.key(seed)
    ks = jax.random.split(key, 24)
    nrm = lambda k, s, sc: jax.random.normal(k, s, jnp.float32) * sc
    return {
        "x_prompt": nrm(ks[0], (BATCH, SEQ, D_MODEL), 1.0),
        "x_sample": nrm(ks[1], (DEC_BATCH, DEC_SEQ, D_MODEL), 1.0),
        "state_pool": nrm(ks[2], (DEPTH, DEC_BATCH, POOL_BUF, D_POOL), 1.0),
        "state_gla": nrm(ks[3], (DEPTH, DEC_BATCH, GLA_HEADS, GLA_DK, GLA_DV), 1.0),
        "state_conv": nrm(ks[4], (DEPTH, DEC_BATCH, CONV_BUF, D_FF), 1.0),
        "meta_tokens": nrm(ks[5], (N_META, D_MODEL), 1.0),
        "w_in": nrm(ks[6], (DEPTH, D_MODEL, D_IN), D_MODEL ** -0.5),
        "w_a2": nrm(ks[7], (DEPTH, GATE_RANK, D_GLA_K), GATE_RANK ** -0.5),
        "b_a": nrm(ks[8], (DEPTH, D_GLA_K), 0.1) + 1.0,
        "w_pool": nrm(ks[9], (DEPTH, N_POOL_GROUPS, POOL_GROUP, POOL_GROUP), POOL_GROUP ** -0.5),
        "pool_scale": 1.0 + nrm(ks[10], (DEPTH, D_POOL), 0.02),
        "gla_norm": 1.0 + nrm(ks[11], (DEPTH, GLA_DV), 0.02),
        "w_out": nrm(ks[12], (DEPTH, D_MODEL, D_MODEL), D_MODEL ** -0.5 * BETA),
        "ln1_g": 1.0 + nrm(ks[13], (DEPTH, D_MODEL), 0.02),
        "ln1_b": nrm(ks[14], (DEPTH, D_MODEL), 0.02),
        "w_up": nrm(ks[15], (DEPTH, D_MODEL, D_FF), D_MODEL ** -0.5),
        "w_gate": nrm(ks[16], (DEPTH, D_MODEL, D_FF), D_MODEL ** -0.5),
        "conv_w": nrm(ks[17], (DEPTH, CONV_W, D_FF), CONV_W ** -0.5),
        "conv_b": nrm(ks[18], (DEPTH, D_FF), 0.02),
        "w_down": nrm(ks[19], (DEPTH, D_FF, D_MODEL), D_FF ** -0.5 * BETA),
        "ln2_g": 1.0 + nrm(ks[20], (DEPTH, D_MODEL), 0.02),
        "ln2_b": nrm(ks[21], (DEPTH, D_MODEL), 0.02),
    }


def reference(x_prompt, x_sample, state_pool, state_gla, state_conv, meta_tokens,
              w_in, w_a2, b_a, w_pool, pool_scale, gla_norm, w_out, ln1_g, ln1_b,
              w_up, w_gate, conv_w, conv_b, w_down, ln2_g, ln2_b):
    B = x_prompt.shape[0]
    meta = jnp.broadcast_to(meta_tokens[None].astype(x_prompt.dtype), (B, N_META, D_MODEL))
    hp = jnp.concatenate([meta, x_prompt], 1)
    hs = x_sample
    pool_empty = jnp.zeros((B, 0, D_POOL), x_prompt.dtype)
    gla_zero = jnp.zeros((B, GLA_HEADS, GLA_DK, GLA_DV), state_gla.dtype)
    conv_zero = jnp.zeros((B, CONV_BUF, D_FF), x_prompt.dtype)
    pp, gp, cp, ps, gs, cs = [], [], [], [], [], []
    for l in range(DEPTH):
        prm = (w_in[l], w_a2[l], b_a[l], w_pool[l], pool_scale[l], gla_norm[l], w_out[l],
               ln1_g[l], ln1_b[l], w_up[l], w_gate[l], conv_w[l], conv_b[l], w_down[l],
               ln2_g[l], ln2_b[l])
        hp, a1, a2, a3 = trunk_layer(hp, pool_empty, gla_zero, conv_zero, 0, True, *prm)
        hs, b1, b2, b3 = trunk_layer(hs, state_pool[l], state_gla[l], state_conv[l], PAST_LEN, False, *prm)
        pp.append(a1); gp.append(a2); cp.append(a3)
        ps.append(b1); gs.append(b2); cs.append(b3)
    y_prompt = hp[:, N_META:]
    return (y_prompt, hs, jnp.stack(pp), jnp.stack(gp), jnp.stack(cp),
            jnp.stack(ps), jnp.stack(gs), jnp.stack(cs))
```

```cpp
#include <hip/hip_runtime.h>
#include <hip/hip_cooperative_groups.h>
#include <cstdio>
#include <cstdint>
namespace cg = cooperative_groups;
namespace pg8 {
#define PG8_LAS __attribute__((address_space(3)))
typedef unsigned short bf16_t;
typedef short bf16x8 __attribute__((ext_vector_type(8)));
typedef float f32x4 __attribute__((ext_vector_type(4)));
typedef unsigned u32x4 __attribute__((ext_vector_type(4)));
constexpr int BM = 256, BK = 64, HALF = 128, HTB = HALF * BK * 2  , STAGE_BYTES = 8 * HTB, NXCD = 8, WGM = 8;

__host__ __device__ __forceinline__ int lds_byte(int r, int c) { const int st = (r >> 4) * 2 + (c >> 5), rr = r & 15, cc = c & 31, ob = rr * 64 + cc * 2; return st * 1024 + (ob ^ (((ob >> 9) & 1) << 5)); }
__host__ __device__ __forceinline__ void stage_rc(int b, int& R, int& C) { const int st = b / 1024, sb = b % 1024, swz = sb ^ (((sb >> 9) & 1) << 5); R = (st >> 1) * 16 + swz / 64; C = (st & 1) * 32 + (swz % 64) / 2; }
__host__ __device__ __forceinline__ int perm32(int rho) { const int n = rho >> 4, i = rho & 15; return 8 * (i >> 2) + 4 * n + (i & 3); }

struct Unit { int pm, pn; };
struct Gemm { const bf16_t* A; const bf16_t* Bt; int M, N, K; };

struct StaticOrder {
    int nM, nN, nwg, G, c;
    __host__ __device__ void init(int M, int N, int G_, int c_) { nM = M / BM; nN = N / BM; nwg = nM * nN; G = G_; c = c_; }
    __host__ __device__ bool next(int i, Unit& u) const {
        const long L = (long)i * G + c; if (L >= nwg) return false;
        int wgid = (int)L; { const int q = nwg / NXCD, r = nwg % NXCD, xcd = wgid % NXCD, off = wgid / NXCD; wgid = (xcd < r ? xcd * (q + 1) : r * (q + 1) + (xcd - r) * q) + off; }
        const int nig = WGM * nN, gid = wgid / nig, fm = gid * WGM, gsz = (nM - fm) < WGM ? (nM - fm) : WGM;
        u.pm = fm + ((wgid % nig) % gsz); u.pn = (wgid % nig) / gsz; return true;
    }
    __device__ __forceinline__ void a_ready(const Unit&) const {}
    __device__ __forceinline__ void done(const Unit&) const {}
};

__device__ __forceinline__ unsigned cvt_pk_bf16(float lo, float hi) { unsigned r; asm volatile("v_cvt_pk_bf16_f32 %0, %1, %2" : "=v"(r) : "v"(lo), "v"(hi)); return r; }
struct EpiBf16 {
    static constexpr bool PERM = true, AFTER_DRAIN = false;
    bf16_t* O; int ldc; int split_cols; size_t split_stride;
    __device__ __forceinline__ void operator()(const f32x4 (&acc)[2][2][4][2], const Unit& u, int wr, int wc, int fr, int fq) const {
        const int row0 = u.pm * BM + wr * 64 + fr; int colt = u.pn * BM; bf16_t* base = O;
        if (split_cols) { const int t = colt / split_cols; base += (size_t)t * split_stride; colt -= t * split_cols; }
        const int col0 = colt + wc * 32 + 8 * fq;
#pragma unroll
        for (int ai = 0; ai < 2; ++ai)
#pragma unroll
            for (int m = 0; m < 4; ++m) { bf16_t* rowp = base + (size_t)(row0 + ai * HALF + m * 16) * ldc + col0;
#pragma unroll
                for (int bj = 0; bj < 2; ++bj) { const f32x4 v0 = acc[ai][bj][m][0], v1 = acc[ai][bj][m][1];
                    u32x4 w; w.x = cvt_pk_bf16(v0[0], v0[1]); w.y = cvt_pk_bf16(v0[2], v0[3]); w.z = cvt_pk_bf16(v1[0], v1[1]); w.w = cvt_pk_bf16(v1[2], v1[3]);
                    *(u32x4*)(rowp + bj * HALF) = w; } }
    }
};
struct EpiRes {
    static constexpr bool PERM = true, AFTER_DRAIN = false;
    bf16_t* XB; float* f32out; float alpha;
    __device__ __forceinline__ void operator()(const f32x4 (&acc)[2][2][4][2], const Unit& u, int wr, int wc, int fr, int fq) const {
        const int row0 = u.pm * BM + wr * 64 + fr, col0 = u.pn * BM + wc * 32 + 8 * fq;
#pragma unroll
        for (int ai = 0; ai < 2; ++ai)
#pragma unroll
            for (int m = 0; m < 4; ++m) { const size_t ro = (size_t)(row0 + ai * HALF + m * 16) * 1024 + col0;
#pragma unroll
                for (int bj = 0; bj < 2; ++bj) {
                    const u32x4 xr = *(const u32x4*)(XB + ro + bj * HALF);
                    f32x4 v0 = acc[ai][bj][m][0], v1 = acc[ai][bj][m][1];
                    v0[0] += alpha * __builtin_bit_cast(float, xr.x << 16); v0[1] += alpha * __builtin_bit_cast(float, xr.x & 0xffff0000u); v0[2] += alpha * __builtin_bit_cast(float, xr.y << 16); v0[3] += alpha * __builtin_bit_cast(float, xr.y & 0xffff0000u);
                    v1[0] += alpha * __builtin_bit_cast(float, xr.z << 16); v1[1] += alpha * __builtin_bit_cast(float, xr.z & 0xffff0000u); v1[2] += alpha * __builtin_bit_cast(float, xr.w << 16); v1[3] += alpha * __builtin_bit_cast(float, xr.w & 0xffff0000u);
                    if (f32out) { *(f32x4*)(f32out + ro + bj * HALF) = v0; *(f32x4*)(f32out + ro + bj * HALF + 4) = v1; }
                    else { u32x4 w; w.x = cvt_pk_bf16(v0[0], v0[1]); w.y = cvt_pk_bf16(v0[2], v0[3]); w.z = cvt_pk_bf16(v1[0], v1[1]); w.w = cvt_pk_bf16(v1[2], v1[3]); *(u32x4*)(XB + ro + bj * HALF) = w; }
                } }
    }
};
struct EpiConv {
    static constexpr bool PERM = true, AFTER_DRAIN = false;
    bf16_t* AUP; bf16_t* GTT; bf16_t* GTOP; bf16_t* GLAST; const float* cw; const float* cb;
    __device__ __forceinline__ void operator()(const f32x4 (&acc)[2][2][4][2], const Unit& u, int wr, int wc, int fr, int fq) const {
        constexpr int FF = 2816;
        const int cch = u.pn * 128 + wc * 32 + 8 * fq;
        if (u.pm >= 64) {
#pragma unroll
            for (int ai = 0; ai < 2; ++ai)
#pragma unroll
                for (int m = 0; m < 4; ++m) {
                    const int row = u.pm * BM + ai * HALF + wr * 64 + m * 16 + fr;
                    const f32x4 a0 = acc[ai][0][m][0], a1 = acc[ai][0][m][1], g0 = acc[ai][1][m][0], g1 = acc[ai][1][m][1];
                    u32x4 w; w.x = cvt_pk_bf16(a0[0], a0[1]); w.y = cvt_pk_bf16(a0[2], a0[3]); w.z = cvt_pk_bf16(a1[0], a1[1]); w.w = cvt_pk_bf16(a1[2], a1[3]);
                    *(u32x4*)(AUP + (size_t)row * FF + cch) = w;
                    w.x = cvt_pk_bf16(g0[0], g0[1]); w.y = cvt_pk_bf16(g0[2], g0[3]); w.z = cvt_pk_bf16(g1[0], g1[1]); w.w = cvt_pk_bf16(g1[2], g1[3]);
                    *(u32x4*)(GTT + (size_t)(row - 16384) * FF + cch) = w;
                }
            return;
        }
        float w0[8], w1[8], w2[8], bb[8];
#pragma unroll
        for (int h = 0; h < 2; ++h) { const f32x4 x0 = *(const f32x4*)(cw + cch + 4 * h), x1 = *(const f32x4*)(cw + FF + cch + 4 * h), x2 = *(const f32x4*)(cw + 2 * FF + cch + 4 * h), xb = *(const f32x4*)(cb + cch + 4 * h);
#pragma unroll
            for (int e = 0; e < 4; ++e) { w0[4 * h + e] = x0[e]; w1[4 * h + e] = x1[e]; w2[4 * h + e] = x2[e]; bb[4 * h + e] = xb[e]; } }
        const int lane = (int)(threadIdx.x & 63);
        const int src1 = ((lane & 48) | ((lane - 1) & 15)) << 2, src2 = ((lane & 48) | ((lane - 2) & 15)) << 2;
#pragma unroll
        for (int ai = 0; ai < 2; ++ai) {
            float pX[8], pY[8];
#pragma unroll
            for (int e = 0; e < 8; ++e) { pX[e] = 0.f; pY[e] = 0.f; }
            const int strip = u.pm * 4 + ai * 2 + wr;
#pragma unroll
            for (int m = 0; m < 4; ++m) {
                const int row = u.pm * BM + ai * HALF + wr * 64 + m * 16 + fr;
                const bool boundary = (m == 0) && (fr < 2);
                float gq[8], gr[8];
#pragma unroll
                for (int e = 0; e < 8; ++e) {
                    const float g = acc[ai][1][m][e >> 2][e & 3], a = acc[ai][0][m][e >> 2][e & 3];
                    const float X = __builtin_bit_cast(float, __builtin_amdgcn_update_dpp(0, __builtin_bit_cast(int, g), 0x121, 0xf, 0xf, false));
                    const float Y = __builtin_bit_cast(float, __builtin_amdgcn_update_dpp(0, __builtin_bit_cast(int, g), 0x122, 0xf, 0xf, false));
                    const float p1 = (fr == 0) ? pX[e] : X, p2 = (fr < 2) ? pY[e] : Y;
                    pX[e] = X; pY[e] = Y;
                    const float gc = bb[e] + w0[e] * p2 + w1[e] * p1 + w2[e] * g;
                    const float sg = gc * __builtin_amdgcn_rcpf(1.f + __expf(-gc));
                    gq[e] = boundary ? a : a * sg; gr[e] = g;
                }
                u32x4 w; w.x = cvt_pk_bf16(gq[0], gq[1]); w.y = cvt_pk_bf16(gq[2], gq[3]); w.z = cvt_pk_bf16(gq[4], gq[5]); w.w = cvt_pk_bf16(gq[6], gq[7]);
                *(u32x4*)(AUP + (size_t)row * FF + cch) = w;
                if (m == 0 || m == 3) {
                    u32x4 wg; wg.x = cvt_pk_bf16(gr[0], gr[1]); wg.y = cvt_pk_bf16(gr[2], gr[3]); wg.z = cvt_pk_bf16(gr[4], gr[5]); wg.w = cvt_pk_bf16(gr[6], gr[7]);
                    if (m == 0 && fr < 2) *(u32x4*)(GTOP + (size_t)(strip * 2 + fr) * FF + cch) = wg;
                    if (m == 3 && fr >= 14) *(u32x4*)(GLAST + (size_t)(strip * 2 + fr - 14) * FF + cch) = wg;
                }
            }
        }
    }
};
template <class Epi, class Sched, bool ALIGN_EPI = false, bool SP2 = false>
__device__ __forceinline__ void gemm_phase(PG8_LAS unsigned char* lds, const Gemm g, const Sched& S, const Epi& E) {
    int tid_o = threadIdx.x; asm volatile("" : "+v"(tid_o)); const int tid = tid_o, wid = __builtin_amdgcn_readfirstlane(tid >> 6), lane = tid & 63, wr = wid >> 2, wc = wid & 3, fr = lane & 15, fq = lane >> 4;
    const int K = g.K, nt = K / BK;
    unsigned voffA[2], voffB[2];
#pragma unroll
    for (int i = 0; i < 2; ++i) { int R, C; stage_rc(tid * 16 + i * 8192, R, C); const int Rb = Epi::PERM ? ((R & ~31) + perm32(R & 31)) : R;
        voffA[i] = (unsigned)(R * K + C) * 2u; voffB[i] = (unsigned)(Rb * K + C) * 2u; }
    const size_t kstep = (size_t)(BK * 2);
    const size_t hstep = (size_t)HALF * K * 2;
    const size_t tstep = 2 * hstep;
    const unsigned ldsw = (unsigned)wid * 1024u;
    const int aoff = lds_byte(wr * 64 + fr, fq * 8), boff = lds_byte(wc * 32 + fr, fq * 8);
#define PG8_SA(b, h) (((b) * 2 + (h)) * HTB)
#define PG8_SB(b, h) ((4 + (b) * 2 + (h)) * HTB)
#define PG8_STAGE(bufoff, gbase, voff) do { _Pragma("unroll") for (int _i = 0; _i < 2; ++_i) \
        __builtin_amdgcn_global_load_lds((const unsigned*)((const char*)(gbase) + (voff)[_i]), (PG8_LAS unsigned*)(lds + (bufoff) + ldsw + _i * 8192), 16, 0, 0); } while (0)
#define PG8_LDA(dst, b, h) do { _Pragma("unroll") for (int m = 0; m < 4; ++m) _Pragma("unroll") for (int k = 0; k < 2; ++k) dst[m][k] = *(const PG8_LAS bf16x8*)(lds + PG8_SA(b, h) + aoff + m * 2048 + k * 1024); } while (0)
#define PG8_LDB(dst, b, h) do { _Pragma("unroll") for (int n = 0; n < 2; ++n) _Pragma("unroll") for (int k = 0; k < 2; ++k) dst[n][k] = *(const PG8_LAS bf16x8*)(lds + PG8_SB(b, h) + boff + n * 2048 + k * 1024); } while (0)
#define PG8_MMA(ai, bj, At, Bt) do { __builtin_amdgcn_s_setprio(1); _Pragma("unroll") for (int m = 0; m < 4; ++m) _Pragma("unroll") for (int n = 0; n < 2; ++n) _Pragma("unroll") for (int k = 0; k < 2; ++k) \
        acc[ai][bj][m][n] = __builtin_amdgcn_mfma_f32_16x16x32_bf16(Bt[n][k], At[m][k], acc[ai][bj][m][n], 0, 0, 0); __builtin_amdgcn_s_setprio(0); } while (0)
#define PG8_WAIT_V(n) asm volatile("s_waitcnt vmcnt(" #n ")" ::: "memory")
#define PG8_WAIT_L(n) asm volatile("s_waitcnt lgkmcnt(" #n ")" ::: "memory")
#define PG8_BAR __builtin_amdgcn_s_barrier()
#define PG8_SCHED __builtin_amdgcn_sched_barrier(0)
    Unit cur, nxt; int ui = 0;
    if (!S.next(0, cur)) return;
    f32x4 acc[2][2][4][2];
#pragma unroll
    for (int a = 0; a < 2; ++a)
#pragma unroll
        for (int b = 0; b < 2; ++b)
#pragma unroll
            for (int m = 0; m < 4; ++m)
#pragma unroll
                for (int n = 0; n < 2; ++n) acc[a][b][m][n] = (f32x4){0.f, 0.f, 0.f, 0.f};
    bf16x8 At[4][2], B0[2][2], B1[2][2];
    const char* cA = (const char*)g.A + (size_t)cur.pm * tstep; const char* cB = (const char*)g.Bt + (size_t)cur.pn * tstep;
    S.a_ready(cur);
    if constexpr (SP2) {
        PG8_STAGE(PG8_SB(0, 0), cB, voffB); PG8_STAGE(PG8_SB(0, 1), cB + hstep, voffB); PG8_STAGE(PG8_SA(0, 0), cA, voffA); PG8_STAGE(PG8_SA(0, 1), cA + hstep, voffA);
        if (wr == 1) PG8_BAR;
        PG8_WAIT_V(2); PG8_BAR;
        PG8_STAGE(PG8_SB(1, 0), cB + kstep, voffB); PG8_STAGE(PG8_SA(1, 0), cA + kstep, voffA); PG8_STAGE(PG8_SB(1, 1), cB + hstep + kstep, voffB);
        PG8_WAIT_V(6); PG8_BAR;
    } else {
        PG8_STAGE(PG8_SB(0, 0), cB, voffB); PG8_STAGE(PG8_SA(0, 0), cA, voffA); PG8_STAGE(PG8_SB(0, 1), cB + hstep, voffB); PG8_STAGE(PG8_SA(0, 1), cA + hstep, voffA);
        if (wr == 1) PG8_BAR;
        PG8_WAIT_V(4); PG8_BAR;
        PG8_STAGE(PG8_SB(1, 0), cB + kstep, voffB); PG8_STAGE(PG8_SA(1, 0), cA + kstep, voffA); PG8_STAGE(PG8_SB(1, 1), cB + hstep + kstep, voffB);
        PG8_WAIT_V(6); PG8_BAR;
    }
    for (;;) {
        const bool has_next = S.next(ui + 1, nxt);
        const char* nA = has_next ? (const char*)g.A + (size_t)nxt.pm * tstep : cA; const char* nB = has_next ? (const char*)g.Bt + (size_t)nxt.pn * tstep : cB;
        for (int t = 0; t < nt; t += 2) {
            const bool last = (t == nt - 2);
            const char* a1 = cA + (size_t)(t + 1) * kstep;
            const char* a2 = last ? nA : cA + (size_t)(t + 2) * kstep; const char* b2 = last ? nB : cB + (size_t)(t + 2) * kstep;
            const char* a3 = a2 + kstep; const char* b3 = b2 + kstep;
            if (last && has_next) S.a_ready(nxt);
            if constexpr (SP2) {
            PG8_LDB(B0, 0, 0); PG8_LDB(B1, 0, 1); PG8_SCHED; PG8_LDA(At, 0, 0); PG8_STAGE(PG8_SA(1, 1), a1 + hstep, voffA);
            PG8_WAIT_V(8); PG8_WAIT_L(0); PG8_BAR; PG8_MMA(0, 0, At, B0); PG8_MMA(0, 1, At, B1); PG8_BAR; PG8_SCHED;
            PG8_LDA(At, 0, 1); PG8_STAGE(PG8_SB(0, 0), b2, voffB); PG8_STAGE(PG8_SB(0, 1), b2 + hstep, voffB); PG8_STAGE(PG8_SA(0, 0), a2, voffA);
            PG8_WAIT_V(8); PG8_WAIT_L(0); PG8_BAR; PG8_MMA(1, 0, At, B0); PG8_MMA(1, 1, At, B1); PG8_BAR; PG8_SCHED;
            PG8_LDB(B0, 1, 0); PG8_LDB(B1, 1, 1); PG8_SCHED; PG8_LDA(At, 1, 0); PG8_STAGE(PG8_SA(0, 1), a2 + hstep, voffA);
            PG8_WAIT_V(8); PG8_WAIT_L(0); PG8_BAR; PG8_MMA(0, 0, At, B0); PG8_MMA(0, 1, At, B1); PG8_BAR; PG8_SCHED;
            PG8_LDA(At, 1, 1); PG8_STAGE(PG8_SB(1, 0), b3, voffB); PG8_STAGE(PG8_SB(1, 1), b3 + hstep, voffB); PG8_STAGE(PG8_SA(1, 0), a3, voffA);
            PG8_WAIT_V(8); PG8_WAIT_L(0); PG8_BAR; PG8_MMA(1, 0, At, B0); PG8_MMA(1, 1, At, B1); PG8_BAR; PG8_SCHED;
            } else {
            PG8_LDB(B0, 0, 0); PG8_SCHED; PG8_LDA(At, 0, 0); PG8_STAGE(PG8_SA(1, 1), a1 + hstep, voffA);
            PG8_WAIT_L(8); PG8_BAR; PG8_WAIT_L(0); PG8_MMA(0, 0, At, B0); PG8_BAR; PG8_SCHED;
            PG8_LDB(B1, 0, 1); PG8_STAGE(PG8_SB(0, 0), b2, voffB);
            PG8_BAR; PG8_WAIT_L(0); PG8_MMA(0, 1, At, B1); PG8_BAR;
            PG8_LDA(At, 0, 1); PG8_STAGE(PG8_SA(0, 0), a2, voffA);
            PG8_BAR; PG8_WAIT_L(0); PG8_MMA(1, 0, At, B0); PG8_BAR; PG8_SCHED;
            PG8_STAGE(PG8_SB(0, 1), b2 + hstep, voffB);
            PG8_WAIT_V(6); PG8_BAR; PG8_MMA(1, 1, At, B1); PG8_BAR;
            PG8_LDB(B0, 1, 0); PG8_SCHED; PG8_LDA(At, 1, 0); PG8_STAGE(PG8_SA(0, 1), a2 + hstep, voffA);
            PG8_WAIT_L(8); PG8_BAR; PG8_WAIT_L(0); PG8_MMA(0, 0, At, B0); PG8_BAR; PG8_SCHED;
            PG8_LDB(B1, 1, 1); PG8_STAGE(PG8_SB(1, 0), b3, voffB);
            PG8_BAR; PG8_WAIT_L(0); PG8_MMA(0, 1, At, B1); PG8_BAR;
            PG8_LDA(At, 1, 1); PG8_STAGE(PG8_SA(1, 0), a3, voffA);
            PG8_BAR; PG8_WAIT_L(0); PG8_MMA(1, 0, At, B0); PG8_BAR; PG8_SCHED;
            PG8_STAGE(PG8_SB(1, 1), b3 + hstep, voffB);
            PG8_WAIT_V(6); PG8_BAR; PG8_MMA(1, 1, At, B1); PG8_BAR;
            }
        }
        if constexpr (ALIGN_EPI) { if (wr == 0) PG8_BAR; }
        if constexpr (!Epi::AFTER_DRAIN) { E(acc, cur, wr, wc, fr, fq); S.done(cur); }
        if (!has_next) break;
#pragma unroll
        for (int a = 0; a < 2; ++a)
#pragma unroll
            for (int b = 0; b < 2; ++b)
#pragma unroll
                for (int m = 0; m < 4; ++m)
#pragma unroll
                    for (int n = 0; n < 2; ++n) acc[a][b][m][n] = (f32x4){0.f, 0.f, 0.f, 0.f};
        cur = nxt; cA = nA; cB = nB; ++ui;
        if constexpr (ALIGN_EPI) { if (wr == 1) PG8_BAR; }
    }
    PG8_WAIT_V(0);
    if constexpr (!ALIGN_EPI) { if (wr == 0) PG8_BAR; }
    PG8_BAR;
    if constexpr (Epi::AFTER_DRAIN) { E.fused(acc, cur, wr, wc, fr, fq, lds, wid, lane); S.done(cur); }
#undef PG8_SA
#undef PG8_SB
#undef PG8_STAGE
#undef PG8_LDA
#undef PG8_LDB
#undef PG8_MMA
#undef PG8_WAIT_V
#undef PG8_WAIT_L
#undef PG8_BAR
#undef PG8_SCHED
}
}
#define LAS __attribute__((address_space(3)))
typedef unsigned short bf16;
typedef short bf16x8 __attribute__((ext_vector_type(8)));
typedef float f32x4 __attribute__((ext_vector_type(4)));
typedef float f32x16 __attribute__((ext_vector_type(16)));
typedef unsigned u32x4 __attribute__((ext_vector_type(4)));
typedef unsigned u32x2 __attribute__((ext_vector_type(2)));

constexpr int DM = 1024, NB = 8, SEQ = 2048, NSB = 128, SL = 4, DPOOL = 512, DFF = 2816, HW = 2048, DIN = 2064;
constexpr int R_META = 16384, R_SAMP = 16400, M_REAL = 16912, MP = 17152;
constexpr int HC_Q = 512, HC_K = 768, HC_V = 1024, HC_R = 1536;
constexpr float ALPHA = 1.41421356237f;
constexpr int NTILE = 265;
constexpr size_t O_YP = 0, O_YS = 16777216, O_PP = 17301504, O_GP = 17424384, O_CP = 17948672, O_PS = 18038784, O_GS = 20004864, O_CS = 28393472;
constexpr size_t MiB = 1u << 20;
constexpr size_t WS_WIN = 1 * MiB, WS_WZ = 5 * MiB, WS_WPOOL = 5 * MiB + 65536, WS_WOUT = 6 * MiB, WS_WUG = 8 * MiB, WS_WDN = 19 * MiB;
constexpr size_t WS_XB = 24 * MiB + 512 * 1024, WS_XTAIL = 58 * MiB, WS_SH = 61 * MiB;
constexpr size_t WS_AUP = WS_SH, WS_GT = WS_SH + (size_t)MP * DFF * 2;
constexpr size_t WS_H = WS_SH, WS_BQ = 128 * MiB, WS_MIX = 145 * MiB, WS_QT = 179 * MiB, WS_KT = 187 * MiB + 512 * 1024, WS_DS = 196 * MiB, WS_SC = 228 * MiB + 256 * 1024, WS_GE = 244 * MiB + 512 * 1024;
constexpr size_t WS_GTT = WS_GT, WS_GTOP = WS_GT + 8 * MiB, WS_GLAST = WS_GT + 16 * MiB;
constexpr size_t WS_END = 256 * MiB;
static_assert(WS_GT + (size_t)MP * DFF * 2 <= WS_END, "ws");
static_assert(WS_H + (size_t)MP * HW * 2 <= WS_BQ && WS_BQ + (size_t)MP * 256 * 4 <= WS_MIX && WS_MIX + (size_t)MP * 1024 * 2 <= WS_QT && WS_QT + (size_t)MP * 512 <= WS_KT && WS_KT + (size_t)MP * 512 <= WS_DS, "ws2");
static_assert(WS_DS + (size_t)257 * 4 * 8192 * 4 <= WS_SC && WS_SC + (size_t)256 * 4 * 8192 * 2 <= WS_GE && WS_GE + 257 * 256 * 4 <= WS_END, "ws3");
static_assert(WS_XB + (size_t)MP * 1024 * 2 <= WS_XTAIL && WS_XTAIL + 768 * 4096 <= WS_SH && WS_WDN + (size_t)1024 * DFF * 2 <= WS_XB, "ws4");
constexpr int LDS_BYTES = 147456;

__device__ __forceinline__ int opaque_tid() { int t = threadIdx.x; asm volatile("" : "+v"(t)); return t; }
__device__ __forceinline__ unsigned f2bf(float f) { unsigned u = __builtin_bit_cast(unsigned, f); return (u + 0x7fffu + ((u >> 16) & 1u)) >> 16; }
__device__ __forceinline__ unsigned pk2(float lo, float hi) { unsigned r; asm("v_cvt_pk_bf16_f32 %0, %1, %2" : "=v"(r) : "v"(lo), "v"(hi)); return r; }
__device__ __forceinline__ float bf2f(bf16 b) { return __builtin_bit_cast(float, (unsigned)b << 16); }
__device__ __forceinline__ float bflo(unsigned w) { return __builtin_bit_cast(float, w << 16); }
__device__ __forceinline__ float bfhi(unsigned w) { return __builtin_bit_cast(float, w & 0xffff0000u); }
__device__ __forceinline__ float wave_sum(float v) {
#pragma unroll
    for (int o = 1; o < 64; o <<= 1) v += __shfl_xor(v, o);
    return v;
}
__device__ __forceinline__ float silu_f(float x) { return x / (1.f + __expf(-x)); }
__device__ __forceinline__ int crow(int reg, int h) { return (reg & 3) + 8 * (reg >> 2) + 4 * h; }
#define MFMA32(a, b, c) __builtin_amdgcn_mfma_f32_32x32x16_bf16((a), (b), (c), 0, 0, 0)

struct Args { const float* in[22]; float* out; unsigned char* ws; };
struct Ctx { const __attribute__((address_space(4))) Args* ka; float* out; unsigned char* ws; };
#define CIN(i) (C.ka->in[i])

__device__ __forceinline__ void tr_item(const float* W, int ldw, int k0, int n0, bf16* WT, int ldt, int dstrow0, LAS float* scr, int lane) {
#pragma unroll
    for (int i = 0; i < 32; ++i) { const int kk = 2 * i + (lane >> 5); scr[kk * 33 + (lane & 31)] = W[(size_t)(k0 + kk) * ldw + n0 + (lane & 31)]; }
    asm volatile("s_waitcnt lgkmcnt(0)" ::: "memory");
    const int c = lane & 7;
#pragma unroll
    for (int j = 0; j < 4; ++j) { const int n = (lane >> 3) + 8 * j; const LAS float* s = scr + (8 * c) * 33 + n;
        u32x4 o; o.x = pk2(s[0 * 33], s[1 * 33]); o.y = pk2(s[2 * 33], s[3 * 33]); o.z = pk2(s[4 * 33], s[5 * 33]); o.w = pk2(s[6 * 33], s[7 * 33]);
        *(u32x4*)(WT + (size_t)(dstrow0 + n0 + n) * ldt + k0 + 8 * c) = o; }
    asm volatile("s_waitcnt lgkmcnt(0)" ::: "memory");
}
__device__ __forceinline__ void convert_weights(const Ctx& C, int l, LAS unsigned char* lds, const int part, const int wg0, const int nwg) {
    const int bidr = (int)blockIdx.x - wg0;
    if (bidr < 0 || bidr >= nwg) return;
    const int tid = opaque_tid(), lane = tid & 63, wave = tid >> 6;
    LAS float* scr = (LAS float*)(lds + wave * 16384);
    const int gw = bidr * 8 + wave, NGW = nwg * 8;
    unsigned char* ws = C.ws;
    const float* w_in = CIN(6) + (size_t)l * DM * DIN; const float* w_out = CIN(12) + (size_t)l * DM * DM;
    const float* w_up = CIN(15) + (size_t)l * DM * DFF; const float* w_gate = CIN(16) + (size_t)l * DM * DFF; const float* w_down = CIN(19) + (size_t)l * DFF * DM;
    const float* w_pool = CIN(9) + (size_t)l * 4 * 128 * 128;
    constexpr int I_IN = 16 * 64, I_OUT = 16 * 32, I_UP = 16 * 88, I_DN = 44 * 32, I_PL = 4 * 2 * 4;
    if (part == 0 || part == 1) {
        for (int it = gw; it < I_IN + I_OUT + I_PL; it += NGW) {
            int r = it;
            if (r < I_IN) { tr_item(w_in, DIN, 64 * (r / 64), 32 * (r % 64), (bf16*)(ws + WS_WIN), 1024, 0, scr, lane); continue; } r -= I_IN;
            if (r < I_OUT) { tr_item(w_out, DM, 64 * (r / 32), 32 * (r % 32), (bf16*)(ws + WS_WOUT), 1024, 0, scr, lane); continue; } r -= I_OUT;
            { const int g = r >> 3, q = r & 7; tr_item(w_pool + (size_t)g * 16384, 128, 64 * (q >> 2), 32 * (q & 3), (bf16*)(ws + WS_WPOOL) + (size_t)g * 16384, 128, 0, scr, lane); }
        }
        bf16* WZ = (bf16*)(ws + WS_WZ);
        for (int i = bidr * 512 + tid; i < 16 * 1024; i += nwg * 512) { const int n = i >> 10, k = i & 1023; WZ[i] = (bf16)f2bf(w_in[(size_t)k * DIN + 2048 + n]); }
    }
    if (part == 0 || part == 2) {
        for (int it = gw; it < 2 * I_UP; it += NGW) {
            int r = it;
            if (r < I_UP) { const int n0 = 32 * (r % 88); tr_item(w_up, DFF, 64 * (r / 88), n0, (bf16*)(ws + WS_WUG), 1024, (n0 >> 7) * 256 + (n0 & 127) - n0, scr, lane); continue; } r -= I_UP;
            { const int n0 = 32 * (r % 88); tr_item(w_gate, DFF, 64 * (r / 88), n0, (bf16*)(ws + WS_WUG), 1024, (n0 >> 7) * 256 + 128 + (n0 & 127) - n0, scr, lane); }
        }
    }
    if (part == 0 || part == 3) {
        for (int r = gw; r < I_DN; r += NGW) tr_item(w_down, DM, 64 * (r / 32), 32 * (r % 32), (bf16*)(ws + WS_WDN), DFF, 0, scr, lane);
    }
}
__device__ __forceinline__ void build_x(const Ctx& C) {
    const int tid = opaque_tid(), lane = tid & 63, wave = tid >> 6;
    const int gw = blockIdx.x * 8 + wave, NGW = gridDim.x * 8;
    bf16* XB = (bf16*)(C.ws + WS_XB);
    for (int row = gw; row < MP; row += NGW) {
        const float* src = nullptr;
        if (row < R_META) src = CIN(0) + (size_t)row * 1024; else if (row < R_SAMP) src = CIN(5) + (size_t)(row - R_META) * 1024; else if (row < M_REAL) src = CIN(1) + (size_t)(row - R_SAMP) * 1024;
#pragma unroll
        for (int j = 0; j < 4; ++j) {
            f32x4 v = src ? *((const f32x4*)src + lane + 64 * j) : (f32x4){0.f, 0.f, 0.f, 0.f};
            u32x2 o; o.x = pk2(v.x, v.y); o.y = pk2(v.z, v.w);
            *((u32x2*)(XB + (size_t)row * 1024) + lane + 64 * j) = o;
        }
    }
}
__device__ __forceinline__ void ln_phase(const Ctx& C, const float* g, const float* b, bool final) {
    const int tid = opaque_tid(), lane = tid & 63, wave = tid >> 6;
    const int gw = blockIdx.x * 8 + wave, NGW = gridDim.x * 8;
    bf16* XB = (bf16*)(C.ws + WS_XB); float* XT = (float*)(C.ws + WS_XTAIL);
    f32x4 gv[4], bv[4];
#pragma unroll
    for (int j = 0; j < 4; ++j) { gv[j] = *((const f32x4*)g + 4 * lane + j); bv[j] = *((const f32x4*)b + 4 * lane + j); }
#pragma unroll 2
    for (int row = gw; row < M_REAL; row += NGW) {
        f32x4 v[4]; float s = 0.f;
        float* xr = row < R_META ? C.out + O_YP + (size_t)row * 1024 : XT + (size_t)(row - R_META) * 1024;
        {
            const u32x4 w0 = *((const u32x4*)(XB + (size_t)row * 1024) + 2 * lane), w1 = *((const u32x4*)(XB + (size_t)row * 1024) + 2 * lane + 1);
            v[0] = (f32x4){bflo(w0.x), bfhi(w0.x), bflo(w0.y), bfhi(w0.y)}; v[1] = (f32x4){bflo(w0.z), bfhi(w0.z), bflo(w0.w), bfhi(w0.w)};
            v[2] = (f32x4){bflo(w1.x), bfhi(w1.x), bflo(w1.y), bfhi(w1.y)}; v[3] = (f32x4){bflo(w1.z), bfhi(w1.z), bflo(w1.w), bfhi(w1.w)};
        }
#pragma unroll
        for (int j = 0; j < 4; ++j) s += (v[j].x + v[j].y) + (v[j].z + v[j].w);
        const float mean = wave_sum(s) * (1.f / 1024.f); float s2 = 0.f;
#pragma unroll
        for (int j = 0; j < 4; ++j) { v[j] = v[j] - mean; s2 += (v[j].x * v[j].x + v[j].y * v[j].y) + (v[j].z * v[j].z + v[j].w * v[j].w); }
        const float rstd = 1.f / sqrtf(wave_sum(s2) * (1.f / 1024.f) + 1e-5f);
#pragma unroll
        for (int j = 0; j < 4; ++j) v[j] = v[j] * rstd * gv[j] + bv[j];
        if (final) {
#pragma unroll
            for (int j = 0; j < 4; ++j) { if (row < R_META) *((f32x4*)xr + 4 * lane + j) = v[j]; else if (row >= R_SAMP) *((f32x4*)(C.out + O_YS + (size_t)(row - R_SAMP) * 1024) + 4 * lane + j) = v[j]; }
        } else {
            u32x4 o0, o1; o0.x = pk2(v[0].x, v[0].y); o0.y = pk2(v[0].z, v[0].w); o0.z = pk2(v[1].x, v[1].y); o0.w = pk2(v[1].z, v[1].w);
            o1.x = pk2(v[2].x, v[2].y); o1.y = pk2(v[2].z, v[2].w); o1.z = pk2(v[3].x, v[3].y); o1.w = pk2(v[3].z, v[3].w);
            *((u32x4*)(XB + (size_t)row * 1024) + 2 * lane) = o0; *((u32x4*)(XB + (size_t)row * 1024) + 2 * lane + 1) = o1;
        }
    }
}
__device__ __forceinline__ void unpack8(const u32x4 w, float (&f)[8]) { f[0] = bflo(w.x); f[1] = bfhi(w.x); f[2] = bflo(w.y); f[3] = bfhi(w.y); f[4] = bflo(w.z); f[5] = bfhi(w.z); f[6] = bflo(w.w); f[7] = bfhi(w.w); }
__device__ __forceinline__ void conv_phase(const Ctx& C, int l) {
    bf16* AUP = (bf16*)(C.ws + WS_AUP); const bf16* GT = (const bf16*)(C.ws + WS_GTT) - (size_t)16384 * DFF;
    const float* cw = CIN(17) + (size_t)l * 3 * DFF; const float* cb = CIN(18) + (size_t)l * DFF;
    const int nthr = gridDim.x * 512;
    for (int id = blockIdx.x * 512 + opaque_tid(); id < 132 * 352; id += nthr) {
        const int q = id / 352, c0 = (id - q * 352) * 8, row0 = R_META + 4 * q;
        float p2[8], p1[8];
        if (q >= 4) { const int sb = q - 4; const float* sc = CIN(4) + ((size_t)(l * NSB + sb) * 2) * DFF + c0;
#pragma unroll
            for (int j = 0; j < 8; ++j) { p2[j] = sc[j]; p1[j] = sc[DFF + j]; } }
        else if (q > 0) { unpack8(*(const u32x4*)(GT + (size_t)(row0 - 2) * DFF + c0), p2); unpack8(*(const u32x4*)(GT + (size_t)(row0 - 1) * DFF + c0), p1); }
        else {
#pragma unroll
            for (int j = 0; j < 8; ++j) { p2[j] = 0.f; p1[j] = 0.f; } }
        u32x4 gtr[4], ar[4];
#pragma unroll
        for (int r = 0; r < 4; ++r) { gtr[r] = *(const u32x4*)(GT + (size_t)(row0 + r) * DFF + c0); ar[r] = *(const u32x4*)(AUP + (size_t)(row0 + r) * DFF + c0); }
        float w0[8], w1[8], w2[8], bb[8];
#pragma unroll
        for (int j = 0; j < 8; ++j) { w0[j] = cw[c0 + j]; w1[j] = cw[DFF + c0 + j]; w2[j] = cw[2 * DFF + c0 + j]; bb[j] = cb[c0 + j]; }
#pragma unroll
        for (int r = 0; r < 4; ++r) {
            float cur[8], a[8], gq[8]; unpack8(gtr[r], cur); unpack8(ar[r], a);
#pragma unroll
            for (int j = 0; j < 8; ++j) { const float gc = bb[j] + w0[j] * p2[j] + w1[j] * p1[j] + w2[j] * cur[j]; gq[j] = a[j] * silu_f(gc); }
            u32x4 o; o.x = pk2(gq[0], gq[1]); o.y = pk2(gq[2], gq[3]); o.z = pk2(gq[4], gq[5]); o.w = pk2(gq[6], gq[7]);
            *(u32x4*)(AUP + (size_t)(row0 + r) * DFF + c0) = o;
            if (q >= 4 && r >= 2) { float* od = C.out + O_CS + ((size_t)(l * NSB + (q - 4)) * 2 + (r - 2)) * DFF + c0;
                *(f32x4*)od = (f32x4){cur[0], cur[1], cur[2], cur[3]}; *(f32x4*)(od + 4) = (f32x4){cur[4], cur[5], cur[6], cur[7]}; }
#pragma unroll
            for (int j = 0; j < 8; ++j) { p2[j] = p1[j]; p1[j] = cur[j]; }
        }
    }
    const bf16* GTOP = (const bf16*)(C.ws + WS_GTOP); const bf16* GLAST = (const bf16*)(C.ws + WS_GLAST);
    for (int id = blockIdx.x * 512 + opaque_tid(); id < 256 * 2 * 352; id += nthr) {
        const int S = id / 704, rr = (id / 352) & 1, c0 = (id % 352) * 8, row = 64 * S + rr, t = row & 2047;
        float p2[8], p1[8], cur[8], a[8];
        if (rr == 0) {
            unpack8(*(const u32x4*)(t == 0 ? GT + (size_t)(R_META + 14) * DFF + c0 : GLAST + (size_t)((S - 1) * 2) * DFF + c0), p2);
            unpack8(*(const u32x4*)(t == 0 ? GT + (size_t)(R_META + 15) * DFF + c0 : GLAST + (size_t)((S - 1) * 2 + 1) * DFF + c0), p1);
        } else {
            unpack8(*(const u32x4*)(t == 1 ? GT + (size_t)(R_META + 15) * DFF + c0 : GLAST + (size_t)((S - 1) * 2 + 1) * DFF + c0), p2);
            unpack8(*(const u32x4*)(GTOP + (size_t)(S * 2) * DFF + c0), p1);
        }
        unpack8(*(const u32x4*)(GTOP + (size_t)(S * 2 + rr) * DFF + c0), cur); unpack8(*(const u32x4*)(AUP + (size_t)row * DFF + c0), a);
        float gq[8];
#pragma unroll
        for (int j = 0; j < 8; ++j) { const float gc = cb[c0 + j] + cw[c0 + j] * p2[j] + cw[DFF + c0 + j] * p1[j] + cw[2 * DFF + c0 + j] * cur[j]; gq[j] = a[j] * silu_f(gc); }
        u32x4 o; o.x = pk2(gq[0], gq[1]); o.y = pk2(gq[2], gq[3]); o.z = pk2(gq[4], gq[5]); o.w = pk2(gq[6], gq[7]);
        *(u32x4*)(AUP + (size_t)row * DFF + c0) = o;
    }
    for (int id = blockIdx.x * 512 + opaque_tid(); id < NB * 2 * 352; id += nthr) {
        const int b = id / 704, j = (id / 352) & 1, c0 = (id % 352) * 8;
        float cur[8]; unpack8(*(const u32x4*)(GLAST + (size_t)((32 * b + 31) * 2 + j) * DFF + c0), cur);
        float* od = C.out + O_CP + ((size_t)(l * NB + b) * 2 + j) * DFF + c0;
        *(f32x4*)od = (f32x4){cur[0], cur[1], cur[2], cur[3]}; *(f32x4*)(od + 4) = (f32x4){cur[4], cur[5], cur[6], cur[7]};
    }
}
__device__ __forceinline__ void fill_vt(const bf16* H, int row0, int CN, LAS bf16* VT, int tid) {
    const int sp = tid & 31, s = 2 * sp, cc0 = tid >> 5;
    u32x4 v0[4], v1[4];
#pragma unroll
    for (int it = 0; it < 4; ++it) {
        const int c0 = 8 * (cc0 + 16 * it);
        v0[it] = s < CN ? *(const u32x4*)(H + (size_t)(row0 + s) * HW + HC_V + c0) : (u32x4){0u, 0u, 0u, 0u};
        v1[it] = (s + 1) < CN ? *(const u32x4*)(H + (size_t)(row0 + s + 1) * HW + HC_V + c0) : (u32x4){0u, 0u, 0u, 0u};
    }
#pragma unroll
    for (int it = 0; it < 4; ++it) {
        const int c0 = 8 * (cc0 + 16 * it);
#pragma unroll
        for (int e = 0; e < 4; ++e) {
            const unsigned a = v0[it][e], b = v1[it][e];
            *(LAS unsigned*)(VT + (c0 + 2 * e) * 72 + s) = (a & 0xffffu) | (b << 16);
            *(LAS unsigned*)(VT + (c0 + 2 * e + 1) * 72 + s) = (a >> 16) | (b & 0xffff0000u);
        }
    }
}
__device__ __forceinline__ void mixA_tile(const Ctx& C, int l, int tile, LAS unsigned char* lds, const int mode, const int hfsel = -1) {
    const int tid = opaque_tid(), lane = tid & 63, wave = __builtin_amdgcn_readfirstlane(tid >> 6), half = lane >> 5, l32 = lane & 31;
    const int kind = tile < 256 ? 0 : (tile == 256 ? 1 : 2);
    const int row0 = kind == 0 ? tile * 64 : (kind == 1 ? R_META : R_SAMP + 64 * (tile - 257));
    const int CN = kind == 1 ? 16 : 64;
    const bf16* XB = (const bf16*)(C.ws + WS_XB); const bf16* H = (const bf16*)(C.ws + WS_H); const bf16* WZ = (const bf16*)(C.ws + WS_WZ); const bf16* WPOOL = (const bf16*)(C.ws + WS_WPOOL);
    bf16* QT = (bf16*)(C.ws + WS_QT); bf16* KT = (bf16*)(C.ws + WS_KT); bf16* MIX = (bf16*)(C.ws + WS_MIX);
    bf16* DS = (bf16*)(C.ws + WS_DS); float* GE = (float*)(C.ws + WS_GE);
    LAS float* ZR = (LAS float*)lds;
    LAS bf16* KDT = (LAS bf16*)(lds + 8192);
    LAS float* BL = (LAS float*)(lds + 45056);
    LAS bf16* VT = (LAS bf16*)(lds + 45056);
    LAS bf16* US = (LAS bf16*)lds;
    LAS bf16* DP = (LAS bf16*)(lds + 40448);
    if (mode != 2) {
    u32x4 q0[2], q1[2], k0[2], k1[2], pv0[4], pv1[4];
    {
        const int sp = tid & 31, s = 2 * sp, cc0 = tid >> 5;
#pragma unroll
        for (int it = 0; it < 2; ++it) {
            const int c0 = 8 * (cc0 + 16 * it);
            const bf16* hp = H + (size_t)(row0 + s) * HW + c0;
            q0[it] = *(const u32x4*)(hp + HC_Q); q1[it] = *(const u32x4*)(hp + HW + HC_Q); k0[it] = *(const u32x4*)(hp + HC_K); k1[it] = *(const u32x4*)(hp + HW + HC_K);
        }
#pragma unroll
        for (int it = 0; it < 4; ++it) {
            const int c0 = 8 * (cc0 + 16 * it);
            pv0[it] = s < CN ? *(const u32x4*)(H + (size_t)(row0 + s) * HW + HC_V + c0) : (u32x4){0u, 0u, 0u, 0u};
            pv1[it] = (s + 1) < CN ? *(const u32x4*)(H + (size_t)(row0 + s + 1) * HW + HC_V + c0) : (u32x4){0u, 0u, 0u, 0u};
        }
    }
    {
        const int rt = wave & 3, kh = wave >> 2, fr = lane & 15, fq = lane >> 4;
        if (16 * rt < CN) {
        const bf16* xa = XB + (size_t)(row0 + 16 * rt + fr) * 1024 + kh * 512 + 8 * fq;
        const bf16* wz = WZ + (size_t)fr * 1024 + kh * 512 + 8 * fq;
        f32x4 acc = (f32x4){0.f, 0.f, 0.f, 0.f};
#pragma unroll 8
        for (int s = 0; s < 16; ++s) { const bf16x8 a = *(const bf16x8*)(wz + 32 * s); const bf16x8 b = *(const bf16x8*)(xa + 32 * s); acc = __builtin_amdgcn_mfma_f32_16x16x32_bf16(a, b, acc, 0, 0, 0); }
        *(LAS f32x4*)(ZR + (kh * 64 + 16 * rt + fr) * 20 + 4 * fq) = acc;
        }
    }
    __syncthreads();
    {
        const float* wa_g = CIN(7) + (size_t)l * 16 * 256;
        const int colz = 32 * wave + l32;
        f32x16 zacc[2];
#pragma unroll
        for (int tm = 0; tm < 2; ++tm)
#pragma unroll
            for (int i = 0; i < 16; ++i) zacc[tm][i] = 0.f;
#pragma unroll
        for (int ks = 0; ks < 8; ++ks) {
            const float bw = wa_g[(2 * ks + half) * 256 + colz];
#pragma unroll
            for (int tm = 0; tm < 2; ++tm)
#pragma unroll
                for (int kh = 0; kh < 2; ++kh) zacc[tm] = __builtin_amdgcn_mfma_f32_32x32x2f32(ZR[(kh * 64 + 32 * tm + l32) * 20 + 2 * ks + half], bw, zacc[tm], 0, 0, 0);
        }
        const float ba = CIN(8)[l * 256 + colz];
#pragma unroll
        for (int tm = 0; tm < 2; ++tm)
#pragma unroll
            for (int i = 0; i < 16; ++i) {
                const float z = zacc[tm][i] + ba;
                BL[(32 * tm + crow(i, half)) * 260 + colz] = (fminf(z, 0.f) - __logf(1.f + __expf(-fabsf(z)))) * (1.f / 16.f);
            }
    }
    __syncthreads();
    {
        const int col = tid & 255, th = tid >> 8;
        const int ntt = (CN - th * 32) < 32 ? ((CN - th * 32) > 0 ? (CN - th * 32) : 0) : 32;
        float bc = 0.f;
#pragma unroll 8
        for (int tt = 0; tt < ntt; ++tt) {
            const int t = th * 32 + tt;
            if (kind == 2 && (tt & 3) == 0) bc = 0.f;
            bc += BL[t * 260 + col];
            BL[t * 260 + col] = bc;
        }
    }
    __syncthreads();
    {
        const int sp = tid & 31, s = 2 * sp, cc0 = tid >> 5;
        const bool addoff = (kind != 2) && (s >= 32);
#pragma unroll
        for (int it = 0; it < 2; ++it) {
            const int c0 = 8 * (cc0 + 16 * it);
            float b0[8], b1[8], be[8], off[8];
#pragma unroll
            for (int e = 0; e < 2; ++e) {
                const f32x4 x0 = *(const LAS f32x4*)(BL + s * 260 + c0 + 4 * e), x1 = *(const LAS f32x4*)(BL + (s + 1) * 260 + c0 + 4 * e);
                const f32x4 o31 = *(const LAS f32x4*)(BL + 31 * 260 + c0 + 4 * e), oe = *(const LAS f32x4*)(BL + (CN - 1) * 260 + c0 + 4 * e);
#pragma unroll
                for (int j = 0; j < 4; ++j) { off[4 * e + j] = addoff ? o31[j] : 0.f; b0[4 * e + j] = x0[j] + off[4 * e + j]; b1[4 * e + j] = x1[j] + off[4 * e + j]; be[4 * e + j] = oe[j] + (CN == 64 ? o31[j] : 0.f); }
            }
            float qf0[8], qf1[8], kf0[8], kf1[8];
            unpack8(q0[it], qf0); unpack8(q1[it], qf1); unpack8(k0[it], kf0); unpack8(k1[it], kf1);
            float e0[8], e1[8];
#pragma unroll
            for (int j = 0; j < 8; ++j) { e0[j] = __expf(b0[j]); e1[j] = __expf(b1[j]); }
            float r0[8], r1[8];
#pragma unroll
            for (int j = 0; j < 8; ++j) { r0[j] = __builtin_amdgcn_rcpf(e0[j]); r1[j] = __builtin_amdgcn_rcpf(e1[j]); }
            if (s < CN) {
                const size_t r = (size_t)(row0 + s);
                u32x4 o;
                o.x = pk2(qf0[0] * 0.125f * e0[0], qf0[1] * 0.125f * e0[1]); o.y = pk2(qf0[2] * 0.125f * e0[2], qf0[3] * 0.125f * e0[3]); o.z = pk2(qf0[4] * 0.125f * e0[4], qf0[5] * 0.125f * e0[5]); o.w = pk2(qf0[6] * 0.125f * e0[6], qf0[7] * 0.125f * e0[7]);
                *(u32x4*)(QT + r * 256 + c0) = o;
                o.x = pk2(qf1[0] * 0.125f * e1[0], qf1[1] * 0.125f * e1[1]); o.y = pk2(qf1[2] * 0.125f * e1[2], qf1[3] * 0.125f * e1[3]); o.z = pk2(qf1[4] * 0.125f * e1[4], qf1[5] * 0.125f * e1[5]); o.w = pk2(qf1[6] * 0.125f * e1[6], qf1[7] * 0.125f * e1[7]);
                *(u32x4*)(QT + (r + 1) * 256 + c0) = o;
                o.x = pk2(kf0[0] * r0[0], kf0[1] * r0[1]); o.y = pk2(kf0[2] * r0[2], kf0[3] * r0[3]); o.z = pk2(kf0[4] * r0[4], kf0[5] * r0[5]); o.w = pk2(kf0[6] * r0[6], kf0[7] * r0[7]);
                *(u32x4*)(KT + r * 256 + c0) = o;
                o.x = pk2(kf1[0] * r1[0], kf1[1] * r1[1]); o.y = pk2(kf1[2] * r1[2], kf1[3] * r1[3]); o.z = pk2(kf1[4] * r1[4], kf1[5] * r1[5]); o.w = pk2(kf1[6] * r1[6], kf1[7] * r1[7]);
                *(u32x4*)(KT + (r + 1) * 256 + c0) = o;
            }
            if (kind != 2) {
#pragma unroll
                for (int j = 0; j < 8; ++j) {
                    const float d0 = s < CN ? kf0[j] * __expf(be[j] - b0[j]) : 0.f, d1 = s < CN ? kf1[j] * __expf(be[j] - b1[j]) : 0.f;
                    *(LAS unsigned*)(KDT + (c0 + j) * 72 + s) = pk2(d0, d1);
                }
                if (s == 0) { *(f32x4*)(GE + tile * 256 + c0) = (f32x4){__expf(be[0]), __expf(be[1]), __expf(be[2]), __expf(be[3])}; *(f32x4*)(GE + tile * 256 + c0 + 4) = (f32x4){__expf(be[4]), __expf(be[5]), __expf(be[6]), __expf(be[7])}; }
            }
        }
    }
    __syncthreads();
    if (kind != 2) {
        {
            const int sp = tid & 31, s = 2 * sp, cc0 = tid >> 5;
#pragma unroll
            for (int it = 0; it < 4; ++it) {
                const int c0 = 8 * (cc0 + 16 * it);
#pragma unroll
                for (int e = 0; e < 4; ++e) {
                    const unsigned a = pv0[it][e], b = pv1[it][e];
                    *(LAS unsigned*)(VT + (c0 + 2 * e) * 72 + s) = (a & 0xffffu) | (b << 16);
                    *(LAS unsigned*)(VT + (c0 + 2 * e + 1) * 72 + s) = (a >> 16) | (b & 0xffff0000u);
                }
            }
        }
        __syncthreads();
        {
            const int h = wave >> 1, dvh = wave & 1;
#pragma unroll
            for (int mt = 0; mt < 2; ++mt)
#pragma unroll
                for (int nt = 0; nt < 2; ++nt) {
                    f32x16 acc;
#pragma unroll
                    for (int i = 0; i < 16; ++i) acc[i] = 0.f;
#pragma unroll
                    for (int ks = 0; ks < 4; ++ks) {
                        const bf16x8 a = *(const LAS bf16x8*)(VT + (h * 128 + dvh * 64 + mt * 32 + l32) * 72 + 16 * ks + 8 * half);
                        const bf16x8 b = *(const LAS bf16x8*)(KDT + (h * 64 + nt * 32 + l32) * 72 + 16 * ks + 8 * half);
                        acc = MFMA32(a, b, acc);
                    }
                    bf16* dp = DS + ((size_t)(tile * 4 + h) * 128 + dvh * 64 + mt * 32) * 64 + nt * 32 + l32;
#pragma unroll
                    for (int i = 0; i < 16; ++i) dp[crow(i, half) * 64] = (bf16)f2bf(acc[i]);
                }
        }
        __syncthreads();
    }
    }
    if (mode == 1) return;
#pragma unroll 1
    for (int hf = (hfsel < 0 ? 0 : hfsel); hf < (hfsel < 0 ? 2 : hfsel + 1); ++hf) {
        const int c = tid & 255, th = tid >> 8, g = 2 * hf + (c >> 7), w = 2 << g; const float invw = 1.f / (float)w;
        if (kind != 2) {
            u32x4 v[5];
#pragma unroll
            for (int i = 0; i < 5; ++i) {
                const int idx = tid + 512 * i, p = idx >> 5, ch = idx & 31, t = p - 15;
                int row = -1;
                if (p < 79) {
                    if (kind == 0) { const int tg = (tile & 31) * 64 + t; row = tg >= 0 ? (tile >> 5) * 2048 + tg : R_META + 16 + tg; }
                    else if (t >= 0 && t < 16) row = R_META + t;
                }
                v[i] = row >= 0 ? *(const u32x4*)(H + (size_t)row * HW + 256 * hf + 8 * ch) : (u32x4){0u, 0u, 0u, 0u};
            }
#pragma unroll
            for (int i = 0; i < 5; ++i) { const int idx = tid + 512 * i, p = idx >> 5, ch = idx & 31; if (p < 79) *(LAS u32x4*)(US + p * 256 + 8 * ch) = v[i]; }
            __syncthreads();
            const int tb = th * 32;
            float s = 0.f;
            for (int j = 1; j < w; ++j) s += bf2f(US[(15 + tb - j) * 256 + c]);
            const bool last = kind == 0 && (tile & 31) == 31;
#pragma unroll 4
            for (int tt = 0; tt < 32; ++tt) {
                const int t = tb + tt;
                const float u = bf2f(US[(15 + t) * 256 + c]); s += u;
                float d;
                if (kind == 0) d = s * invw - u; else { const int cnt = (t + 1) < w ? (t + 1) : w; d = s / (float)cnt - u; }
                DP[t * 264 + c] = (bf16)f2bf(d);
                s -= bf2f(US[(15 + t - w + 1) * 256 + c]);
                if (last && t >= 49) C.out[O_PP + ((size_t)(l * NB + (tile >> 5)) * 15 + (t - 49)) * 512 + 256 * hf + c] = u;
            }
        } else {
            const int cg = 256 * hf + c;
#pragma unroll 2
            for (int qq = 0; qq < 8; ++qq) {
                const int q = th * 8 + qq, sb = (tile - 257) * 16 + q, r0 = row0 + 4 * q;
                const float* pv = CIN(2) + ((size_t)(l * NSB + sb) * 15) * 512 + cg;
                float* po = C.out + O_PS + ((size_t)(l * NSB + sb) * 15) * 512 + cg;
                float pr[15], u[4];
#pragma unroll
                for (int j = 0; j < 15; ++j) pr[j] = pv[j * 512];
#pragma unroll
                for (int t = 0; t < 4; ++t) u[t] = bf2f(H[(size_t)(r0 + t) * HW + cg]);
#pragma unroll
                for (int j = 0; j < 11; ++j) po[j * 512] = pr[4 + j];
#pragma unroll
                for (int t = 0; t < 4; ++t) po[(11 + t) * 512] = u[t];
#pragma unroll
                for (int t = 0; t < 4; ++t) {
                    float s = 0.f;
#pragma unroll
                    for (int i = 0; i < 19; ++i) { const float fv = i < 15 ? pr[i < 15 ? i : 0] : u[i >= 15 ? i - 15 : 0]; s += (i <= 15 + t && i > 15 + t - w) ? fv : 0.f; }
                    DP[(4 * q + t) * 264 + c] = (bf16)f2bf(s * invw - u[t]);
                }
            }
        }
        __syncthreads();
        {
            const int gl = wave >> 2, qn = wave & 3, gg = 2 * hf + gl;
            const bf16* WP = WPOOL + (size_t)gg * 16384;
            f32x16 acc[2];
#pragma unroll
            for (int b = 0; b < 2; ++b)
#pragma unroll
                for (int i = 0; i < 16; ++i) acc[b][i] = 0.f;
#pragma unroll
            for (int ks = 0; ks < 8; ++ks) {
                const bf16x8 a = *(const bf16x8*)(WP + (size_t)(32 * qn + l32) * 128 + 16 * ks + 8 * half);
#pragma unroll
                for (int tt = 0; tt < 2; ++tt) { const bf16x8 bb = *(const LAS bf16x8*)(DP + (32 * tt + l32) * 264 + gl * 128 + 16 * ks + 8 * half); acc[tt] = MFMA32(a, bb, acc[tt]); }
            }
#pragma unroll
            for (int tt = 0; tt < 2; ++tt) {
                const int t = 32 * tt + l32;
                if (t < CN) {
                    bf16* mp = MIX + (size_t)(row0 + t) * 1024 + gg * 128;
#pragma unroll
                    for (int i4 = 0; i4 < 4; ++i4) {
                        const int n0 = 32 * qn + 8 * i4 + 4 * half;
                        const f32x4 ps = *(const f32x4*)(CIN(10) + l * 512 + gg * 128 + n0);
                        u32x2 o; o.x = pk2(acc[tt][4 * i4] * ps.x, acc[tt][4 * i4 + 1] * ps.y); o.y = pk2(acc[tt][4 * i4 + 2] * ps.z, acc[tt][4 * i4 + 3] * ps.w);
                        *(u32x2*)(mp + n0) = o;
                    }
                }
            }
        }
        __syncthreads();
    }
}
__device__ __forceinline__ void scan_phase(const Ctx& C, int l) {
    const bf16* DS = (const bf16*)(C.ws + WS_DS); const float* GE = (const float*)(C.ws + WS_GE); bf16* SC = (bf16*)(C.ws + WS_SC);
    const int nthr = gridDim.x * 512;
    for (int e0 = blockIdx.x * 512 + opaque_tid(); e0 < 131072; e0 += nthr) {
        const int e1 = e0 + 131072;
        const int hd0 = e0 & 8191, h0 = (e0 >> 13) & 3, b0 = e0 >> 15, dk0 = e0 & 63, dv0 = (e0 >> 6) & 127;
        const int hd1 = e1 & 8191, h1 = (e1 >> 13) & 3, b1 = e1 >> 15, dk1 = e1 & 63, dv1 = (e1 >> 6) & 127;
        float S0 = bf2f(DS[((size_t)256 * 4 + h0) * 8192 + hd0]), S1 = bf2f(DS[((size_t)256 * 4 + h1) * 8192 + hd1]);
#pragma unroll 8
        for (int c = 0; c < 32; ++c) {
            const int ci0 = b0 * 32 + c, ci1 = b1 * 32 + c; const size_t o0 = ((size_t)ci0 * 4 + h0) * 8192 + hd0, o1 = ((size_t)ci1 * 4 + h1) * 8192 + hd1;
            SC[o0] = (bf16)f2bf(S0); SC[o1] = (bf16)f2bf(S1);
            S0 = GE[ci0 * 256 + h0 * 64 + dk0] * S0 + bf2f(DS[o0]); S1 = GE[ci1 * 256 + h1 * 64 + dk1] * S1 + bf2f(DS[o1]);
        }
        C.out[O_GP + ((size_t)((l * NB + b0) * 4 + h0) * 64 + dk0) * 128 + dv0] = S0;
        C.out[O_GP + ((size_t)((l * NB + b1) * 4 + h1) * 64 + dk1) * 128 + dv1] = S1;
    }
}
__device__ __forceinline__ void glaC_tile(const Ctx& C, int l, int tile, LAS unsigned char* lds) {
    const int tid = opaque_tid(), lane = tid & 63, wave = __builtin_amdgcn_readfirstlane(tid >> 6), half = lane >> 5, l32 = lane & 31;
    const int kind = tile < 256 ? 0 : 1;
    const int row0 = kind == 0 ? tile * 64 : R_META;
    const int CN = kind == 1 ? 16 : 64;
    const bf16* H = (const bf16*)(C.ws + WS_H); const bf16* QT = (const bf16*)(C.ws + WS_QT); const bf16* KT = (const bf16*)(C.ws + WS_KT); const bf16* SC = (const bf16*)(C.ws + WS_SC);
    bf16* MIX = (bf16*)(C.ws + WS_MIX);
    LAS bf16* VT = (LAS bf16*)lds;
    LAS bf16* P = (LAS bf16*)(lds + 73728);
    fill_vt(H, row0, CN, VT, tid);
    const int h = wave >> 1, th = wave & 1, T0 = 32 * th;
    bf16x8 QF[4];
#pragma unroll
    for (int ks = 0; ks < 4; ++ks) QF[ks] = *(const bf16x8*)(QT + (size_t)(row0 + T0 + l32) * 256 + h * 64 + 16 * ks + 8 * half);
    {
        const int t = T0 + l32;
        for (int sj = 0; sj <= th; ++sj) {
            f32x16 acc;
#pragma unroll
            for (int i = 0; i < 16; ++i) acc[i] = 0.f;
#pragma unroll
            for (int ks = 0; ks < 4; ++ks) { const bf16x8 a = *(const bf16x8*)(KT + (size_t)(row0 + 32 * sj + l32) * 256 + h * 64 + 16 * ks + 8 * half); acc = MFMA32(a, QF[ks], acc); }
#pragma unroll
            for (int i4 = 0; i4 < 4; ++i4) {
                const int s0 = 32 * sj + 8 * i4 + 4 * half;
                const float v0 = (s0 <= t) ? acc[4 * i4] : 0.f, v1 = (s0 + 1 <= t) ? acc[4 * i4 + 1] : 0.f, v2 = (s0 + 2 <= t) ? acc[4 * i4 + 2] : 0.f, v3 = (s0 + 3 <= t) ? acc[4 * i4 + 3] : 0.f;
                u32x2 o; o.x = pk2(v0, v1); o.y = pk2(v2, v3);
                *(LAS u32x2*)(P + (h * 64 + t) * 72 + s0) = o;
            }
        }
    }
    __syncthreads();
    f32x16 o[4];
#pragma unroll
    for (int n = 0; n < 4; ++n)
#pragma unroll
        for (int i = 0; i < 16; ++i) o[n][i] = 0.f;
    const int nks = 2 * (th + 1);
    for (int ks = 0; ks < nks; ++ks) {
        const bf16x8 b = *(const LAS bf16x8*)(P + (h * 64 + T0 + l32) * 72 + 16 * ks + 8 * half);
#pragma unroll
        for (int n = 0; n < 4; ++n) { const bf16x8 a = *(const LAS bf16x8*)(VT + (h * 128 + 32 * n + l32) * 72 + 16 * ks + 8 * half); o[n] = MFMA32(a, b, o[n]); }
    }
    if (kind == 0) {
#pragma unroll
        for (int ks = 0; ks < 4; ++ks)
#pragma unroll
            for (int n = 0; n < 4; ++n) { const bf16x8 a = *(const bf16x8*)(SC + ((size_t)(tile * 4 + h) * 128 + 32 * n + l32) * 64 + 16 * ks + 8 * half); o[n] = MFMA32(a, QF[ks], o[n]); }
    }
    float ss = 0.f;
#pragma unroll
    for (int n = 0; n < 4; ++n)
#pragma unroll
        for (int i = 0; i < 16; ++i) ss += o[n][i] * o[n][i];
    ss += __shfl_xor(ss, 32);
    const float rinv = rsqrtf(ss * (1.f / 128.f) + 1e-6f);
    {
        const int t = T0 + l32;
        if (t < CN) {
            const size_t row = (size_t)(row0 + t);
#pragma unroll
            for (int n = 0; n < 4; ++n)
#pragma unroll
                for (int i4 = 0; i4 < 4; ++i4) {
                    const int dv0 = 32 * n + 8 * i4 + 4 * half;
                    const u32x2 rr = *(const u32x2*)(H + row * HW + HC_R + h * 128 + dv0);
                    const f32x4 gn = *(const f32x4*)(CIN(11) + l * 128 + dv0);
                    const float y0 = o[n][4 * i4] * rinv * gn.x * silu_f(bflo(rr.x)), y1 = o[n][4 * i4 + 1] * rinv * gn.y * silu_f(bfhi(rr.x));
                    const float y2 = o[n][4 * i4 + 2] * rinv * gn.z * silu_f(bflo(rr.y)), y3 = o[n][4 * i4 + 3] * rinv * gn.w * silu_f(bfhi(rr.y));
                    u32x2 ov; ov.x = pk2(y0, y1); ov.y = pk2(y2, y3);
                    *(u32x2*)(MIX + row * 1024 + 512 + h * 128 + dv0) = ov;
                }
        }
    }
    __syncthreads();
}
__device__ __forceinline__ void gla_sample_item(const Ctx& C, int l, int j, LAS unsigned char* lds) {
    const int tid = opaque_tid(), lane = tid & 63;
    const int sb = j >> 1, hp = j & 1, hl = tid >> 8, dh = (tid >> 7) & 1, dv = tid & 127, h = hp * 2 + hl;
    const int r0 = R_SAMP + sb * 4;
    const bf16* H = (const bf16*)(C.ws + WS_H); bf16* MIX = (bf16*)(C.ws + WS_MIX);
    LAS float* QS = (LAS float*)lds;
    LAS float* KD = QS + 512;
    LAS float* GEe = KD + 512;
    LAS float* AT = GEe + 128;
    LAS float* OP = AT + 32;
    LAS float* RS = OP + 2048;
    LAS float* ZRs = RS + 16;
    {
        const bf16* XBp = (const bf16*)(C.ws + WS_XB); const bf16* WZ = (const bf16*)(C.ws + WS_WZ);
        const int t = tid >> 7, jz = (tid >> 3) & 15, kp = tid & 7;
        const bf16* xp = XBp + (size_t)(r0 + t) * 1024 + kp * 128; const bf16* wp = WZ + (size_t)jz * 1024 + kp * 128;
        float acc = 0.f;
#pragma unroll 4
        for (int i = 0; i < 16; ++i) { float xf[8], wf[8]; unpack8(*(const u32x4*)(xp + 8 * i), xf); unpack8(*(const u32x4*)(wp + 8 * i), wf);
#pragma unroll
            for (int e = 0; e < 8; ++e) acc += xf[e] * wf[e]; }
        acc += __shfl_xor(acc, 1); acc += __shfl_xor(acc, 2); acc += __shfl_xor(acc, 4);
        if (kp == 0) ZRs[t * 16 + jz] = acc;
    }
    __syncthreads();
    if (tid < 128) {
        const int hq = tid >> 6, d = tid & 63, col = (hp * 2 + hq) * 64 + d;
        float b[4], q[4], k[4];
        {
            float wa[16];
#pragma unroll
            for (int jj = 0; jj < 16; ++jj) wa[jj] = CIN(7)[(size_t)(l * 16 + jj) * 256 + col];
            const float ba = CIN(8)[l * 256 + col];
            float bc = 0.f;
#pragma unroll
            for (int t = 0; t < 4; ++t) { float z = ba;
#pragma unroll
                for (int jj = 0; jj < 16; ++jj) z += ZRs[t * 16 + jj] * wa[jj];
                bc += (fminf(z, 0.f) - __logf(1.f + __expf(-fabsf(z)))) * (1.f / 16.f); b[t] = bc; }
        }

#pragma unroll
        for (int t = 0; t < 4; ++t) { q[t] = bf2f(H[(size_t)(r0 + t) * HW + HC_Q + col]) * 0.125f; k[t] = bf2f(H[(size_t)(r0 + t) * HW + HC_K + col]); }
#pragma unroll
        for (int t = 0; t < 4; ++t) { QS[(hq * 4 + t) * 64 + d] = q[t] * __expf(b[t]); KD[(hq * 4 + t) * 64 + d] = k[t] * __expf(b[3] - b[t]); }
        GEe[hq * 64 + d] = __expf(b[3]);
#pragma unroll
        for (int t = 0; t < 4; ++t)
#pragma unroll
            for (int s = 0; s < 4; ++s) {
                float p = (s <= t) ? q[t] * k[s] * __expf(b[t] - b[s]) : 0.f;
                p = wave_sum(p);
                if (d == 0) AT[(hq * 4 + t) * 4 + s] = p;
            }
    }
    __syncthreads();
    float v[4];
#pragma unroll
    for (int s = 0; s < 4; ++s) v[s] = bf2f(H[(size_t)(r0 + s) * HW + HC_V + h * 128 + dv]);
    {
        const float* S0 = CIN(3) + ((size_t)((l * NSB + sb) * 4 + h) * 64) * 128 + dv;
        float* SO = C.out + O_GS + ((size_t)((l * NSB + sb) * 4 + h) * 64) * 128 + dv;
        float o0 = 0.f, o1 = 0.f, o2 = 0.f, o3 = 0.f;
#pragma unroll 16
        for (int dd = 0; dd < 32; ++dd) {
            const int d = dh * 32 + dd;
            const float s0 = S0[(size_t)d * 128];
            o0 += QS[(hl * 4 + 0) * 64 + d] * s0; o1 += QS[(hl * 4 + 1) * 64 + d] * s0; o2 += QS[(hl * 4 + 2) * 64 + d] * s0; o3 += QS[(hl * 4 + 3) * 64 + d] * s0;
            const float sn = GEe[hl * 64 + d] * s0 + KD[(hl * 4 + 0) * 64 + d] * v[0] + KD[(hl * 4 + 1) * 64 + d] * v[1] + KD[(hl * 4 + 2) * 64 + d] * v[2] + KD[(hl * 4 + 3) * 64 + d] * v[3];
            SO[(size_t)d * 128] = sn;
        }
        OP[((hl * 2 + dh) * 4 + 0) * 128 + dv] = o0; OP[((hl * 2 + dh) * 4 + 1) * 128 + dv] = o1; OP[((hl * 2 + dh) * 4 + 2) * 128 + dv] = o2; OP[((hl * 2 + dh) * 4 + 3) * 128 + dv] = o3;
    }
    __syncthreads();
    float oo[2];
#pragma unroll
    for (int e = 0; e < 2; ++e) {
        const int t = 2 * dh + e;
        float o = OP[((hl * 2 + 0) * 4 + t) * 128 + dv] + OP[((hl * 2 + 1) * 4 + t) * 128 + dv];
#pragma unroll
        for (int s = 0; s < 4; ++s) o += (s <= t) ? AT[(hl * 4 + t) * 4 + s] * v[s] : 0.f;
        oo[e] = o;
        const float ssq = wave_sum(o * o);
        if (lane == 0) RS[(hl * 4 + t) * 2 + ((tid >> 6) & 1)] = ssq;
    }
    __syncthreads();
#pragma unroll
    for (int e = 0; e < 2; ++e) {
        const int t = 2 * dh + e;
        const float tot = RS[(hl * 4 + t) * 2] + RS[(hl * 4 + t) * 2 + 1];
        const float rinv = rsqrtf(tot * (1.f / 128.f) + 1e-6f);
        const float r = bf2f(H[(size_t)(r0 + t) * HW + HC_R + h * 128 + dv]);
        MIX[(size_t)(r0 + t) * 1024 + 512 + h * 128 + dv] = (bf16)f2bf(oo[e] * rinv * CIN(11)[l * 128 + dv] * silu_f(r));
    }
    __syncthreads();
}
struct MiniRes {
    bf16* XB; float* xt; float alpha;
    __device__ __forceinline__ void operator()(int trow, int col, f32x4 v) const {
        bf16* p = XB + (size_t)(R_META + trow) * 1024 + col; const u32x2 xr = *(const u32x2*)p;
        v.x += alpha * bflo(xr.x); v.y += alpha * bfhi(xr.x); v.z += alpha * bflo(xr.y); v.w += alpha * bfhi(xr.y);
        if (xt) *(f32x4*)(xt + (size_t)trow * 1024 + col) = v; else { u32x2 o; o.x = pk2(v.x, v.y); o.y = pk2(v.z, v.w); *(u32x2*)p = o; }
    }
};
struct MiniBf16 {
    bf16* O; int ldc;
    __device__ __forceinline__ void operator()(int trow, int col, f32x4 v) const { u32x2 o; o.x = pk2(v.x, v.y); o.y = pk2(v.z, v.w); *(u32x2*)(O + (size_t)(R_META + trow) * ldc + col) = o; }
};
template <class EpiT> __device__ __forceinline__ void mini_gemm(const bf16* A, const bf16* Bt, int K, int N, LAS unsigned char* lds, const EpiT& E) {
    const int tid = opaque_tid(), lane = tid & 63, wave = __builtin_amdgcn_readfirstlane(tid >> 6), fr = lane & 15, fq = lane >> 4;
    const int npn = N / 64, npieces = 11 * npn, kw = K / 8, nks = kw / 32;
    LAS float* P = (LAS float*)lds;
    for (int pc = blockIdx.x; pc < npieces; pc += gridDim.x) {
        const int pm = pc / npn, pn = pc - pm * npn;
        const bf16* ap = A + (size_t)(R_META + 48 * pm + fr) * K + wave * kw + 8 * fq;
        const bf16* bp = Bt + (size_t)(64 * pn + fr) * K + wave * kw + 8 * fq;
        f32x4 acc[3][4];
#pragma unroll
        for (int m = 0; m < 3; ++m)
#pragma unroll
            for (int n = 0; n < 4; ++n) acc[m][n] = (f32x4){0.f, 0.f, 0.f, 0.f};
#pragma unroll 4
        for (int ks = 0; ks < nks; ++ks) {
            bf16x8 a[3], b[4];
#pragma unroll
            for (int m = 0; m < 3; ++m) a[m] = *(const bf16x8*)(ap + (size_t)(16 * m) * K + 32 * ks);
#pragma unroll
            for (int n = 0; n < 4; ++n) b[n] = *(const bf16x8*)(bp + (size_t)(16 * n) * K + 32 * ks);
#pragma unroll
            for (int m = 0; m < 3; ++m)
#pragma unroll
                for (int n = 0; n < 4; ++n) acc[m][n] = __builtin_amdgcn_mfma_f32_16x16x32_bf16(b[n], a[m], acc[m][n], 0, 0, 0);
        }
#pragma unroll
        for (int m = 0; m < 3; ++m)
#pragma unroll
            for (int n = 0; n < 4; ++n) *(LAS f32x4*)(P + (wave * 48 + 16 * m + fr) * 68 + 16 * n + 4 * fq) = acc[m][n];
        __syncthreads();
        for (int g = tid; g < 768; g += 512) {
            const int row = g >> 4, c4 = (g & 15) * 4;
            f32x4 v = *(const LAS f32x4*)(P + row * 68 + c4);
#pragma unroll
            for (int w = 1; w < 8; ++w) v += *(const LAS f32x4*)(P + (w * 48 + row) * 68 + c4);
            E(48 * pm + row, 64 * pn + c4, v);
        }
        __syncthreads();
    }
}
#define XB_TMO      128
#define XB_XCNT(j)  (256  + 64 * (j))
#define XB_XSUB(j)  (1280 + 64 * (j))
#define XB_XGEN(j)  (2304 + 64 * (j))
#define XB_TOP      3328
#define XB_TOPGEN   3392
#define XCD_BAR_WORDS 3456
#define XB_SPIN_CAP (1u << 18)

__device__ __forceinline__ unsigned xb_ld(unsigned* p)              { return __hip_atomic_load(p, __ATOMIC_RELAXED, __HIP_MEMORY_SCOPE_AGENT); }
__device__ __forceinline__ unsigned xb_add(unsigned* p, unsigned v) { return __hip_atomic_fetch_add(p, v, __ATOMIC_RELAXED, __HIP_MEMORY_SCOPE_AGENT); }
__device__ __forceinline__ unsigned xb_xcc_id() { return (unsigned)__builtin_amdgcn_s_getreg((3 << 11) | 20) & 0xFu; }
#define XB_SPIN(cond, bar) do { unsigned _sp = 0; while (cond) { __builtin_amdgcn_s_sleep(1); \
    if ((++_sp & 255u) == 0u) { if (xb_ld(&(bar)[XB_TMO])) break; if (_sp > XB_SPIN_CAP) { atomicAdd(&(bar)[XB_TMO], 1u); break; } } } } while (0)

struct XcdBarrier {
    unsigned* bar; unsigned x;
    volatile LAS unsigned* st;
};

__device__ __forceinline__ XcdBarrier xcd_barrier_post(unsigned* bar, volatile LAS unsigned* st) {
    XcdBarrier b; b.bar = bar; b.x = xb_xcc_id(); b.st = st;
    if (threadIdx.x == 0) (void)xb_add(&bar[XB_XCNT(b.x)], 1u);
    return b;
}
__device__ __forceinline__ void xcd_barrier_complete(unsigned* bar, unsigned x, unsigned& nloc, unsigned& nx) {
    const unsigned G = gridDim.x * gridDim.y * gridDim.z;
    unsigned sum, cnt, mine, sp = 0u;
    for (;;) {
        sum = 0u; cnt = 0u; mine = 0u;
#pragma unroll
        for (unsigned j = 0; j < 16; ++j) { const unsigned c = xb_ld(&bar[XB_XCNT(j)]); sum += c; cnt += (c > 0u) ? 1u : 0u; mine = (j == x) ? c : mine; }
        if (sum == G) break;
        __builtin_amdgcn_s_sleep(1);
        if ((++sp & 255u) == 0u) { if (xb_ld(&bar[XB_TMO])) break; if (sp > XB_SPIN_CAP) { atomicAdd(&bar[XB_TMO], 1u); break; } }
    }
    nloc = mine > 0u ? mine : 1u; nx = cnt > 0u ? cnt : 1u;
}

__device__ __forceinline__ void xcd_barrier(const XcdBarrier& b) {
    asm volatile("s_waitcnt vmcnt(0)" ::: "memory");
    __syncthreads();
    if (threadIdx.x == 0) {
        unsigned* bar = b.bar;
        __builtin_amdgcn_s_waitcnt(0);
        unsigned nloc = b.st[0], nx = b.st[1];
        if (nloc == 0u) { xcd_barrier_complete(bar, b.x, nloc, nx); b.st[0] = nloc; b.st[1] = nx; }
        const unsigned old = xb_add(&bar[XB_XSUB(b.x)], 1u);
        const unsigned gen = old / nloc;
        if (old + 1u == (gen + 1u) * nloc) {
            __builtin_amdgcn_fence(__ATOMIC_RELEASE, "agent");
            asm volatile("s_waitcnt vmcnt(0)" ::: "memory");
            const unsigned og = xb_add(&bar[XB_TOP], 1u);
            const unsigned tg = og / nx;
            if (og + 1u == (tg + 1u) * nx) xb_add(&bar[XB_TOPGEN], 1u);
            else XB_SPIN(xb_ld(&bar[XB_TOPGEN]) == tg, bar);
            __builtin_amdgcn_fence(__ATOMIC_ACQUIRE, "agent");
            xb_add(&bar[XB_XGEN(b.x)], 1u);
            asm volatile("s_waitcnt vmcnt(0)" ::: "memory");
        } else {
            XB_SPIN(xb_ld(&bar[XB_XGEN(b.x)]) == gen, bar);
            __builtin_amdgcn_fence(__ATOMIC_ACQUIRE, "agent");
            asm volatile("s_waitcnt vmcnt(0)" ::: "memory");
        }
    }
    __syncthreads();
}
#define GSYNC() xcd_barrier(bar)
template <int l> __device__ __forceinline__ void layer_body(const Ctx& C, const XcdBarrier& bar, LAS unsigned char* lds, unsigned char* ws, const pg8::bf16_t* XB, float* XT, const int G, const int bid) {
        {
            { MiniBf16 ME{(bf16*)(ws + WS_H), HW}; mini_gemm(XB, (const bf16*)(ws + WS_WIN), 1024, HW, lds, ME); }
            pg8::Gemm g{XB, (const pg8::bf16_t*)(ws + WS_WIN), 16384, HW, 1024}; pg8::StaticOrder S; S.init(16384, HW, G, bid);
            pg8::EpiBf16 E{(pg8::bf16_t*)(ws + WS_H), HW, 0, 0};
            pg8::gemm_phase<pg8::EpiBf16, pg8::StaticOrder, true, true>(lds, g, S, E);
        }
        GSYNC();
        for (int tile = bid; tile < 257; tile += G) mixA_tile(C, l, tile, lds, (tile == 256 || tile == 0) ? 1 : 0);
        GSYNC();
        scan_phase(C, l);
        {
            const int r = G - 1 - bid;
            if (r < 16) mixA_tile(C, l, 257 + (r >> 1), lds, 2, r & 1);
            else if (r < 18) mixA_tile(C, l, 256, lds, 2, r & 1);
            else if (r < 20) mixA_tile(C, l, 0, lds, 2, r & 1);
            else if (r == 20) glaC_tile(C, l, 256, lds);
        }
        GSYNC();
        for (int tile = bid; tile < 256; tile += G) glaC_tile(C, l, tile, lds);
        for (int j = bid; j < 256; j += G) gla_sample_item(C, l, j, lds);
        GSYNC();
        {
            { MiniRes ME{(bf16*)(ws + WS_XB), nullptr, ALPHA}; mini_gemm((const bf16*)(ws + WS_MIX), (const bf16*)(ws + WS_WOUT), 1024, 1024, lds, ME); }
            pg8::Gemm g{(const pg8::bf16_t*)(ws + WS_MIX), (const pg8::bf16_t*)(ws + WS_WOUT), 16384, 1024, 1024}; pg8::StaticOrder S; S.init(16384, 1024, G, bid);
            pg8::EpiRes E{(pg8::bf16_t*)(ws + WS_XB), nullptr, ALPHA};
            pg8::gemm_phase<pg8::EpiRes, pg8::StaticOrder, true, true>(lds, g, S, E);
        }
        GSYNC();
        ln_phase(C, CIN(13) + l * 1024, CIN(14) + l * 1024, false);
        GSYNC();
        {
            pg8::Gemm g{XB, (const pg8::bf16_t*)(ws + WS_WUG), MP, 2 * DFF, 1024}; pg8::StaticOrder S; S.init(MP, 2 * DFF, G, bid);
            pg8::EpiConv E{(pg8::bf16_t*)(ws + WS_AUP), (pg8::bf16_t*)(ws + WS_GTT), (pg8::bf16_t*)(ws + WS_GTOP), (pg8::bf16_t*)(ws + WS_GLAST), CIN(17) + (size_t)l * 3 * DFF, CIN(18) + (size_t)l * DFF};
            pg8::gemm_phase<pg8::EpiConv, pg8::StaticOrder, true, true>(lds, g, S, E);
        }
        if (l == 0) { const int rem = (67 * 22) % G; convert_weights(C, 1, lds, 1, rem, G - rem); }
        GSYNC();
        conv_phase(C, l);
        GSYNC();
        {
            { MiniRes ME{(bf16*)(ws + WS_XB), nullptr, ALPHA}; mini_gemm((const bf16*)(ws + WS_AUP), (const bf16*)(ws + WS_WDN), DFF, 1024, lds, ME); }
            pg8::Gemm g{(const pg8::bf16_t*)(ws + WS_AUP), (const pg8::bf16_t*)(ws + WS_WDN), 16384, 1024, DFF}; pg8::StaticOrder S; S.init(16384, 1024, G, bid);
            pg8::EpiRes E{(pg8::bf16_t*)(ws + WS_XB), nullptr, ALPHA};
            pg8::gemm_phase<pg8::EpiRes, pg8::StaticOrder, true, true>(lds, g, S, E);
        }
        if (l == 0) { const int w0 = G > 176 ? 176 : 0; convert_weights(C, 1, lds, 2, w0, G - w0); }
        GSYNC();
        ln_phase(C, CIN(20) + l * 1024, CIN(21) + l * 1024, l == 1);
        if (l == 0) { convert_weights(C, 1, lds, 3, 0, G); GSYNC(); }
}
#ifndef USE_COOP
#define USE_COOP 1
#endif
__global__ void __launch_bounds__(512, 2) hybrid_fwd(Args a) {
    extern __shared__ __attribute__((aligned(16))) unsigned char lds_raw[];
    LAS unsigned char* lds = (LAS unsigned char*)lds_raw;
#if USE_COOP
    cg::grid_group grid = cg::this_grid();
#endif
    Ctx C;
    C.ka = (const __attribute__((address_space(4))) Args*)__builtin_amdgcn_kernarg_segment_ptr(); C.out = a.out; C.ws = a.ws;
    const int G = gridDim.x, bid = blockIdx.x;
    unsigned char* ws = a.ws;
    const pg8::bf16_t* XB = (const pg8::bf16_t*)(ws + WS_XB);
    float* XT = (float*)(ws + WS_XTAIL);

    if (threadIdx.x < 16) ((LAS unsigned*)(lds + LDS_BYTES - 64))[threadIdx.x] = 0u;
    __syncthreads();
    XcdBarrier bar = xcd_barrier_post((unsigned*)ws, (volatile LAS unsigned*)(lds + LDS_BYTES - 64));
#if USE_COOP
    grid.sync();
#endif
    convert_weights(C, 0, lds, 0, 0, G);
    build_x(C);
    GSYNC();
    layer_body<0>(C, bar, lds, ws, XB, XT, G, bid);
    layer_body<1>(C, bar, lds, ws, XB, XT, G, bid);
}

extern "C" void kernel_launch(void* const* d_in, const int* in_sizes, int n_in, void* d_out, int out_size, void* d_ws, size_t ws_size, hipStream_t stream) {
    static int grid = 0;
    if (grid == 0) {
        if (n_in != 22 || ws_size < WS_END) { fprintf(stderr, "kernel_launch: unexpected n_in %d / ws_size %zu\n", n_in, ws_size); grid = -1; return; }
        int dev = 0, cus = 0, per_cu = 0;
        hipGetDevice(&dev); hipDeviceGetAttribute(&cus, hipDeviceAttributeMultiprocessorCount, dev);
        if (hipFuncSetAttribute((const void*)hybrid_fwd, hipFuncAttributeMaxDynamicSharedMemorySize, LDS_BYTES) != hipSuccess) { fprintf(stderr, "kernel_launch: hipFuncSetAttribute failed\n"); grid = -1; return; }
        if (hipOccupancyMaxActiveBlocksPerMultiprocessor(&per_cu, (const void*)hybrid_fwd, 512, LDS_BYTES) != hipSuccess || per_cu < 1) { fprintf(stderr, "kernel_launch: occupancy query says %d blocks/CU\n", per_cu); (void)hipGetLastError(); per_cu = 1; }
        grid = cus;
        if (grid > cus * per_cu) grid = cus * per_cu;
        fprintf(stderr, "kernel_launch: grid %d (cus %d, per_cu %d)\n", grid, cus, per_cu);
    }
    if (grid < 0) return;
    if (hipMemsetAsync(d_ws, 0, 65536, stream) != hipSuccess) { fprintf(stderr, "kernel_launch: memset failed\n"); return; }
    Args a{};
    for (int i = 0; i < 22; ++i) a.in[i] = (const float*)d_in[i];
    a.out = (float*)d_out; a.ws = (unsigned char*)d_ws;
#if USE_COOP
    void* args[] = {&a};
    hipError_t e = hipLaunchCooperativeKernel((const void*)hybrid_fwd, dim3(grid), dim3(512), args, LDS_BYTES, stream);
    if (e != hipSuccess) fprintf(stderr, "cooperative launch failed: %s (grid %d)\n", hipGetErrorString(e), grid);
#else
    hipLaunchKernelGGL(hybrid_fwd, dim3(grid), dim3(512), LDS_BYTES, stream, a);
#endif
}
```

```cpp
#include <hip/hip_runtime.h>
#include <hip/hip_cooperative_groups.h>
#include <cstdio>
#include <cstdint>
namespace cg = cooperative_groups;
namespace pg8 {
#define PG8_LAS __attribute__((address_space(3)))
typedef unsigned short bf16_t;
typedef short bf16x8 __attribute__((ext_vector_type(8)));
typedef float f32x4 __attribute__((ext_vector_type(4)));
typedef unsigned u32x4 __attribute__((ext_vector_type(4)));
constexpr int BM = 256, BK = 64, HALF = 128, HTB = HALF * BK * 2  , STAGE_BYTES = 8 * HTB, NXCD = 8, WGM = 8;

__host__ __device__ __forceinline__ int lds_byte(int r, int c) { const int st = (r >> 4) * 2 + (c >> 5), rr = r & 15, cc = c & 31, ob = rr * 64 + cc * 2; return st * 1024 + (ob ^ (((ob >> 9) & 1) << 5)); }
__host__ __device__ __forceinline__ void stage_rc(int b, int& R, int& C) { const int st = b / 1024, sb = b % 1024, swz = sb ^ (((sb >> 9) & 1) << 5); R = (st >> 1) * 16 + swz / 64; C = (st & 1) * 32 + (swz % 64) / 2; }
__host__ __device__ __forceinline__ int perm32(int rho) { const int n = rho >> 4, i = rho & 15; return 8 * (i >> 2) + 4 * n + (i & 3); }

struct Unit { int pm, pn; };
struct Gemm { const bf16_t* A; const bf16_t* Bt; int M, N, K; };

struct StaticOrder {
    int nM, nN, nwg, G, c;
    __host__ __device__ void init(int M, int N, int G_, int c_) { nM = M / BM; nN = N / BM; nwg = nM * nN; G = G_; c = c_; }
    __host__ __device__ bool next(int i, Unit& u) const {
        const long L = (long)i * G + c; if (L >= nwg) return false;
        int wgid = (int)L; { const int q = nwg / NXCD, r = nwg % NXCD, xcd = wgid % NXCD, off = wgid / NXCD; wgid = (xcd < r ? xcd * (q + 1) : r * (q + 1) + (xcd - r) * q) + off; }
        const int nig = WGM * nN, gid = wgid / nig, fm = gid * WGM, gsz = (nM - fm) < WGM ? (nM - fm) : WGM;
        u.pm = fm + ((wgid % nig) % gsz); u.pn = (wgid % nig) / gsz; return true;
    }
    __device__ __forceinline__ void a_ready(const Unit&) const {}
    __device__ __forceinline__ void done(const Unit&) const {}
};

__device__ __forceinline__ unsigned cvt_pk_bf16(float lo, float hi) { unsigned r; asm volatile("v_cvt_pk_bf16_f32 %0, %1, %2" : "=v"(r) : "v"(lo), "v"(hi)); return r; }
struct EpiBf16 {
    static constexpr bool PERM = true, AFTER_DRAIN = false;
    bf16_t* O; int ldc; int split_cols; size_t split_stride;
    __device__ __forceinline__ void operator()(const f32x4 (&acc)[2][2][4][2], const Unit& u, int wr, int wc, int fr, int fq) const {
        const int row0 = u.pm * BM + wr * 64 + fr; int colt = u.pn * BM; bf16_t* base = O;
        if (split_cols) { const int t = colt / split_cols; base += (size_t)t * split_stride; colt -= t * split_cols; }
        const int col0 = colt + wc * 32 + 8 * fq;
#pragma unroll
        for (int ai = 0; ai < 2; ++ai)
#pragma unroll
            for (int m = 0; m < 4; ++m) { bf16_t* rowp = base + (size_t)(row0 + ai * HALF + m * 16) * ldc + col0;
#pragma unroll
                for (int bj = 0; bj < 2; ++bj) { const f32x4 v0 = acc[ai][bj][m][0], v1 = acc[ai][bj][m][1];
                    u32x4 w; w.x = cvt_pk_bf16(v0[0], v0[1]); w.y = cvt_pk_bf16(v0[2], v0[3]); w.z = cvt_pk_bf16(v1[0], v1[1]); w.w = cvt_pk_bf16(v1[2], v1[3]);
                    *(u32x4*)(rowp + bj * HALF) = w; } }
    }
};
struct EpiRes {
    static constexpr bool PERM = true, AFTER_DRAIN = false;
    bf16_t* XB; float* f32out; float alpha;
    __device__ __forceinline__ void operator()(const f32x4 (&acc)[2][2][4][2], const Unit& u, int wr, int wc, int fr, int fq) const {
        const int row0 = u.pm * BM + wr * 64 + fr, col0 = u.pn * BM + wc * 32 + 8 * fq;
#pragma unroll
        for (int ai = 0; ai < 2; ++ai)
#pragma unroll
            for (int m = 0; m < 4; ++m) { const size_t ro = (size_t)(row0 + ai * HALF + m * 16) * 1024 + col0;
#pragma unroll
                for (int bj = 0; bj < 2; ++bj) {
                    const u32x4 xr = *(const u32x4*)(XB + ro + bj * HALF);
                    f32x4 v0 = acc[ai][bj][m][0], v1 = acc[ai][bj][m][1];
                    v0[0] += alpha * __builtin_bit_cast(float, xr.x << 16); v0[1] += alpha * __builtin_bit_cast(float, xr.x & 0xffff0000u); v0[2] += alpha * __builtin_bit_cast(float, xr.y << 16); v0[3] += alpha * __builtin_bit_cast(float, xr.y & 0xffff0000u);
                    v1[0] += alpha * __builtin_bit_cast(float, xr.z << 16); v1[1] += alpha * __builtin_bit_cast(float, xr.z & 0xffff0000u); v1[2] += alpha * __builtin_bit_cast(float, xr.w << 16); v1[3] += alpha * __builtin_bit_cast(float, xr.w & 0xffff0000u);
                    if (f32out) { *(f32x4*)(f32out + ro + bj * HALF) = v0; *(f32x4*)(f32out + ro + bj * HALF + 4) = v1; }
                    else { u32x4 w; w.x = cvt_pk_bf16(v0[0], v0[1]); w.y = cvt_pk_bf16(v0[2], v0[3]); w.z = cvt_pk_bf16(v1[0], v1[1]); w.w = cvt_pk_bf16(v1[2], v1[3]); *(u32x4*)(XB + ro + bj * HALF) = w; }
                } }
    }
};
struct EpiConv {
    static constexpr bool PERM = true, AFTER_DRAIN = false;
    bf16_t* AUP; bf16_t* GTT; bf16_t* GTOP; bf16_t* GLAST; const float* cw; const float* cb;
    __device__ __forceinline__ void operator()(const f32x4 (&acc)[2][2][4][2], const Unit& u, int wr, int wc, int fr, int fq) const {
        constexpr int FF = 2816;
        const int cch = u.pn * 128 + wc * 32 + 8 * fq;
        if (u.pm >= 64) {
#pragma unroll
            for (int ai = 0; ai < 2; ++ai)
#pragma unroll
                for (int m = 0; m < 4; ++m) {
                    const int row = u.pm * BM + ai * HALF + wr * 64 + m * 16 + fr;
                    const f32x4 a0 = acc[ai][0][m][0], a1 = acc[ai][0][m][1], g0 = acc[ai][1][m][0], g1 = acc[ai][1][m][1];
                    u32x4 w; w.x = cvt_pk_bf16(a0[0], a0[1]); w.y = cvt_pk_bf16(a0[2], a0[3]); w.z = cvt_pk_bf16(a1[0], a1[1]); w.w = cvt_pk_bf16(a1[2], a1[3]);
                    *(u32x4*)(AUP + (size_t)row * FF + cch) = w;
                    w.x = cvt_pk_bf16(g0[0], g0[1]); w.y = cvt_pk_bf16(g0[2], g0[3]); w.z = cvt_pk_bf16(g1[0], g1[1]); w.w = cvt_pk_bf16(g1[2], g1[3]);
                    *(u32x4*)(GTT + (size_t)(row - 16384) * FF + cch) = w;
                }
            return;
        }
        float w0[8], w1[8], w2[8], bb[8];
#pragma unroll
        for (int h = 0; h < 2; ++h) { const f32x4 x0 = *(const f32x4*)(cw + cch + 4 * h), x1 = *(const f32x4*)(cw + FF + cch + 4 * h), x2 = *(const f32x4*)(cw + 2 * FF + cch + 4 * h), xb = *(const f32x4*)(cb + cch + 4 * h);
#pragma unroll
            for (int e = 0; e < 4; ++e) { w0[4 * h + e] = x0[e]; w1[4 * h + e] = x1[e]; w2[4 * h + e] = x2[e]; bb[4 * h + e] = xb[e]; } }
        const int lane = (int)(threadIdx.x & 63);
        const int src1 = ((lane & 48) | ((lane - 1) & 15)) << 2, src2 = ((lane & 48) | ((lane - 2) & 15)) << 2;
#pragma unroll
        for (int ai = 0; ai < 2; ++ai) {
            float pX[8], pY[8];
#pragma unroll
            for (int e = 0; e < 8; ++e) { pX[e] = 0.f; pY[e] = 0.f; }
            const int strip = u.pm * 4 + ai * 2 + wr;
#pragma unroll
            for (int m = 0; m < 4; ++m) {
                const int row = u.pm * BM + ai * HALF + wr * 64 + m * 16 + fr;
                const bool boundary = (m == 0) && (fr < 2);
                float gq[8], gr[8];
#pragma unroll
                for (int e = 0; e < 8; ++e) {
                    const float g = acc[ai][1][m][e >> 2][e & 3], a = acc[ai][0][m][e >> 2][e & 3];
                    const float X = __builtin_bit_cast(float, __builtin_amdgcn_ds_bpermute(src1, __builtin_bit_cast(int, g)));
                    const float Y = __builtin_bit_cast(float, __builtin_amdgcn_ds_bpermute(src2, __builtin_bit_cast(int, g)));
                    const float p1 = (fr == 0) ? pX[e] : X, p2 = (fr < 2) ? pY[e] : Y;
                    pX[e] = X; pY[e] = Y;
                    const float gc = bb[e] + w0[e] * p2 + w1[e] * p1 + w2[e] * g;
                    const float sg = gc * __builtin_amdgcn_rcpf(1.f + __expf(-gc));
                    gq[e] = boundary ? a : a * sg; gr[e] = g;
                }
                u32x4 w; w.x = cvt_pk_bf16(gq[0], gq[1]); w.y = cvt_pk_bf16(gq[2], gq[3]); w.z = cvt_pk_bf16(gq[4], gq[5]); w.w = cvt_pk_bf16(gq[6], gq[7]);
                *(u32x4*)(AUP + (size_t)row * FF + cch) = w;
                if (m == 0 || m == 3) {
                    u32x4 wg; wg.x = cvt_pk_bf16(gr[0], gr[1]); wg.y = cvt_pk_bf16(gr[2], gr[3]); wg.z = cvt_pk_bf16(gr[4], gr[5]); wg.w = cvt_pk_bf16(gr[6], gr[7]);
                    if (m == 0 && fr < 2) *(u32x4*)(GTOP + (size_t)(strip * 2 + fr) * FF + cch) = wg;
                    if (m == 3 && fr >= 14) *(u32x4*)(GLAST + (size_t)(strip * 2 + fr - 14) * FF + cch) = wg;
                }
            }
        }
    }
};
template <class Epi, class Sched, bool ALIGN_EPI = false, bool SP2 = false>
__device__ __forceinline__ void gemm_phase(PG8_LAS unsigned char* lds, const Gemm g, const Sched& S, const Epi& E) {
    int tid_o = threadIdx.x; asm volatile("" : "+v"(tid_o)); const int tid = tid_o, wid = __builtin_amdgcn_readfirstlane(tid >> 6), lane = tid & 63, wr = wid >> 2, wc = wid & 3, fr = lane & 15, fq = lane >> 4;
    const int K = g.K, nt = K / BK;
    unsigned voffA[2], voffB[2];
#pragma unroll
    for (int i = 0; i < 2; ++i) { int R, C; stage_rc(tid * 16 + i * 8192, R, C); const int Rb = Epi::PERM ? ((R & ~31) + perm32(R & 31)) : R;
        voffA[i] = (unsigned)(R * K + C) * 2u; voffB[i] = (unsigned)(Rb * K + C) * 2u; }
    const size_t kstep = (size_t)(BK * 2);
    const size_t hstep = (size_t)HALF * K * 2;
    const size_t tstep = 2 * hstep;
    const unsigned ldsw = (unsigned)wid * 1024u;
    const int aoff = lds_byte(wr * 64 + fr, fq * 8), boff = lds_byte(wc * 32 + fr, fq * 8);
#define PG8_SA(b, h) (((b) * 2 + (h)) * HTB)
#define PG8_SB(b, h) ((4 + (b) * 2 + (h)) * HTB)
#define PG8_STAGE(bufoff, gbase, voff) do { _Pragma("unroll") for (int _i = 0; _i < 2; ++_i) \
        __builtin_amdgcn_global_load_lds((const unsigned*)((const char*)(gbase) + (voff)[_i]), (PG8_LAS unsigned*)(lds + (bufoff) + ldsw + _i * 8192), 16, 0, 0); } while (0)
#define PG8_LDA(dst, b, h) do { _Pragma("unroll") for (int m = 0; m < 4; ++m) _Pragma("unroll") for (int k = 0; k < 2; ++k) dst[m][k] = *(const PG8_LAS bf16x8*)(lds + PG8_SA(b, h) + aoff + m * 2048 + k * 1024); } while (0)
#define PG8_LDB(dst, b, h) do { _Pragma("unroll") for (int n = 0; n < 2; ++n) _Pragma("unroll") for (int k = 0; k < 2; ++k) dst[n][k] = *(const PG8_LAS bf16x8*)(lds + PG8_SB(b, h) + boff + n * 2048 + k * 1024); } while (0)
#define PG8_MMA(ai, bj, At, Bt) do { __builtin_amdgcn_s_setprio(1); _Pragma("unroll") for (int m = 0; m < 4; ++m) _Pragma("unroll") for (int n = 0; n < 2; ++n) _Pragma("unroll") for (int k = 0; k < 2; ++k) \
        acc[ai][bj][m][n] = __builtin_amdgcn_mfma_f32_16x16x32_bf16(Bt[n][k], At[m][k], acc[ai][bj][m][n], 0, 0, 0); __builtin_amdgcn_s_setprio(0); } while (0)
#define PG8_WAIT_V(n) asm volatile("s_waitcnt vmcnt(" #n ")" ::: "memory")
#define PG8_WAIT_L(n) asm volatile("s_waitcnt lgkmcnt(" #n ")" ::: "memory")
#define PG8_BAR __builtin_amdgcn_s_barrier()
#define PG8_SCHED __builtin_amdgcn_sched_barrier(0)
    Unit cur, nxt; int ui = 0;
    if (!S.next(0, cur)) return;
    f32x4 acc[2][2][4][2];
#pragma unroll
    for (int a = 0; a < 2; ++a)
#pragma unroll
        for (int b = 0; b < 2; ++b)
#pragma unroll
            for (int m = 0; m < 4; ++m)
#pragma unroll
                for (int n = 0; n < 2; ++n) acc[a][b][m][n] = (f32x4){0.f, 0.f, 0.f, 0.f};
    bf16x8 At[4][2], B0[2][2], B1[2][2];
    const char* cA = (const char*)g.A + (size_t)cur.pm * tstep; const char* cB = (const char*)g.Bt + (size_t)cur.pn * tstep;
    S.a_ready(cur);
    if constexpr (SP2) {
        PG8_STAGE(PG8_SB(0, 0), cB, voffB); PG8_STAGE(PG8_SB(0, 1), cB + hstep, voffB); PG8_STAGE(PG8_SA(0, 0), cA, voffA); PG8_STAGE(PG8_SA(0, 1), cA + hstep, voffA);
        if (wr == 1) PG8_BAR;
        PG8_WAIT_V(2); PG8_BAR;
        PG8_STAGE(PG8_SB(1, 0), cB + kstep, voffB); PG8_STAGE(PG8_SA(1, 0), cA + kstep, voffA); PG8_STAGE(PG8_SB(1, 1), cB + hstep + kstep, voffB);
        PG8_WAIT_V(6); PG8_BAR;
    } else {
        PG8_STAGE(PG8_SB(0, 0), cB, voffB); PG8_STAGE(PG8_SA(0, 0), cA, voffA); PG8_STAGE(PG8_SB(0, 1), cB + hstep, voffB); PG8_STAGE(PG8_SA(0, 1), cA + hstep, voffA);
        if (wr == 1) PG8_BAR;
        PG8_WAIT_V(4); PG8_BAR;
        PG8_STAGE(PG8_SB(1, 0), cB + kstep, voffB); PG8_STAGE(PG8_SA(1, 0), cA + kstep, voffA); PG8_STAGE(PG8_SB(1, 1), cB + hstep + kstep, voffB);
        PG8_WAIT_V(6); PG8_BAR;
    }
    for (;;) {
        const bool has_next = S.next(ui + 1, nxt);
        const char* nA = has_next ? (const char*)g.A + (size_t)nxt.pm * tstep : cA; const char* nB = has_next ? (const char*)g.Bt + (size_t)nxt.pn * tstep : cB;
        for (int t = 0; t < nt; t += 2) {
            const bool last = (t == nt - 2);
            const char* a1 = cA + (size_t)(t + 1) * kstep;
            const char* a2 = last ? nA : cA + (size_t)(t + 2) * kstep; const char* b2 = last ? nB : cB + (size_t)(t + 2) * kstep;
            const char* a3 = a2 + kstep; const char* b3 = b2 + kstep;
            if (last && has_next) S.a_ready(nxt);
            if constexpr (SP2) {
            PG8_LDB(B0, 0, 0); PG8_LDB(B1, 0, 1); PG8_SCHED; PG8_LDA(At, 0, 0); PG8_STAGE(PG8_SA(1, 1), a1 + hstep, voffA);
            PG8_WAIT_V(8); PG8_WAIT_L(0); PG8_BAR; PG8_MMA(0, 0, At, B0); PG8_MMA(0, 1, At, B1); PG8_BAR; PG8_SCHED;
            PG8_LDA(At, 0, 1); PG8_STAGE(PG8_SB(0, 0), b2, voffB); PG8_STAGE(PG8_SB(0, 1), b2 + hstep, voffB); PG8_STAGE(PG8_SA(0, 0), a2, voffA);
            PG8_WAIT_V(8); PG8_WAIT_L(0); PG8_BAR; PG8_MMA(1, 0, At, B0); PG8_MMA(1, 1, At, B1); PG8_BAR; PG8_SCHED;
            PG8_LDB(B0, 1, 0); PG8_LDB(B1, 1, 1); PG8_SCHED; PG8_LDA(At, 1, 0); PG8_STAGE(PG8_SA(0, 1), a2 + hstep, voffA);
            PG8_WAIT_V(8); PG8_WAIT_L(0); PG8_BAR; PG8_MMA(0, 0, At, B0); PG8_MMA(0, 1, At, B1); PG8_BAR; PG8_SCHED;
            PG8_LDA(At, 1, 1); PG8_STAGE(PG8_SB(1, 0), b3, voffB); PG8_STAGE(PG8_SB(1, 1), b3 + hstep, voffB); PG8_STAGE(PG8_SA(1, 0), a3, voffA);
            PG8_WAIT_V(8); PG8_WAIT_L(0); PG8_BAR; PG8_MMA(1, 0, At, B0); PG8_MMA(1, 1, At, B1); PG8_BAR; PG8_SCHED;
            } else {
            PG8_LDB(B0, 0, 0); PG8_SCHED; PG8_LDA(At, 0, 0); PG8_STAGE(PG8_SA(1, 1), a1 + hstep, voffA);
            PG8_WAIT_L(8); PG8_BAR; PG8_WAIT_L(0); PG8_MMA(0, 0, At, B0); PG8_BAR; PG8_SCHED;
            PG8_LDB(B1, 0, 1); PG8_STAGE(PG8_SB(0, 0), b2, voffB);
            PG8_BAR; PG8_WAIT_L(0); PG8_MMA(0, 1, At, B1); PG8_BAR;
            PG8_LDA(At, 0, 1); PG8_STAGE(PG8_SA(0, 0), a2, voffA);
            PG8_BAR; PG8_WAIT_L(0); PG8_MMA(1, 0, At, B0); PG8_BAR; PG8_SCHED;
            PG8_STAGE(PG8_SB(0, 1), b2 + hstep, voffB);
            PG8_WAIT_V(6); PG8_BAR; PG8_MMA(1, 1, At, B1); PG8_BAR;
            PG8_LDB(B0, 1, 0); PG8_SCHED; PG8_LDA(At, 1, 0); PG8_STAGE(PG8_SA(0, 1), a2 + hstep, voffA);
            PG8_WAIT_L(8); PG8_BAR; PG8_WAIT_L(0); PG8_MMA(0, 0, At, B0); PG8_BAR; PG8_SCHED;
            PG8_LDB(B1, 1, 1); PG8_STAGE(PG8_SB(1, 0), b3, voffB);
            PG8_BAR; PG8_WAIT_L(0); PG8_MMA(0, 1, At, B1); PG8_BAR;
            PG8_LDA(At, 1, 1); PG8_STAGE(PG8_SA(1, 0), a3, voffA);
            PG8_BAR; PG8_WAIT_L(0); PG8_MMA(1, 0, At, B0); PG8_BAR; PG8_SCHED;
            PG8_STAGE(PG8_SB(1, 1), b3 + hstep, voffB);
            PG8_WAIT_V(6); PG8_BAR; PG8_MMA(1, 1, At, B1); PG8_BAR;
            }
        }
        if constexpr (ALIGN_EPI) { if (wr == 0) PG8_BAR; }
        if constexpr (!Epi::AFTER_DRAIN) { E(acc, cur, wr, wc, fr, fq); S.done(cur); }
        if (!has_next) break;
#pragma unroll
        for (int a = 0; a < 2; ++a)
#pragma unroll
            for (int b = 0; b < 2; ++b)
#pragma unroll
                for (int m = 0; m < 4; ++m)
#pragma unroll
                    for (int n = 0; n < 2; ++n) acc[a][b][m][n] = (f32x4){0.f, 0.f, 0.f, 0.f};
        cur = nxt; cA = nA; cB = nB; ++ui;
        if constexpr (ALIGN_EPI) { if (wr == 1) PG8_BAR; }
    }
    PG8_WAIT_V(0);
    if constexpr (!ALIGN_EPI) { if (wr == 0) PG8_BAR; }
    PG8_BAR;
    if constexpr (Epi::AFTER_DRAIN) { E.fused(acc, cur, wr, wc, fr, fq, lds, wid, lane); S.done(cur); }
#undef PG8_SA
#undef PG8_SB
#undef PG8_STAGE
#undef PG8_LDA
#undef PG8_LDB
#undef PG8_MMA
#undef PG8_WAIT_V
#undef PG8_WAIT_L
#undef PG8_BAR
#undef PG8_SCHED
}
}
#define LAS __attribute__((address_space(3)))
typedef unsigned short bf16;
typedef short bf16x8 __attribute__((ext_vector_type(8)));
typedef float f32x4 __attribute__((ext_vector_type(4)));
typedef float f32x16 __attribute__((ext_vector_type(16)));
typedef unsigned u32x4 __attribute__((ext_vector_type(4)));
typedef unsigned u32x2 __attribute__((ext_vector_type(2)));

constexpr int DM = 1024, NB = 8, SEQ = 2048, NSB = 128, SL = 4, DPOOL = 512, DFF = 2816, HW = 2048, DIN = 2064;
constexpr int R_META = 16384, R_SAMP = 16400, M_REAL = 16912, MP = 17152;
constexpr int HC_Q = 512, HC_K = 768, HC_V = 1024, HC_R = 1536;
constexpr float ALPHA = 1.41421356237f;
constexpr int NTILE = 265;
constexpr size_t O_YP = 0, O_YS = 16777216, O_PP = 17301504, O_GP = 17424384, O_CP = 17948672, O_PS = 18038784, O_GS = 20004864, O_CS = 28393472;
constexpr size_t MiB = 1u << 20;
constexpr size_t WS_WIN = 1 * MiB, WS_WZ = 5 * MiB, WS_WPOOL = 5 * MiB + 65536, WS_WOUT = 6 * MiB, WS_WUG = 8 * MiB, WS_WDN = 19 * MiB;
constexpr size_t WS_XB = 24 * MiB + 512 * 1024, WS_XTAIL = 58 * MiB, WS_SH = 61 * MiB;
constexpr size_t WS_AUP = WS_SH, WS_GT = WS_SH + (size_t)MP * DFF * 2;
constexpr size_t WS_H = WS_SH, WS_BQ = 128 * MiB, WS_MIX = 145 * MiB, WS_QT = 179 * MiB, WS_KT = 187 * MiB + 512 * 1024, WS_DS = 196 * MiB, WS_SC = 228 * MiB + 256 * 1024, WS_GE = 244 * MiB + 512 * 1024;
constexpr size_t WS_GTT = WS_GT, WS_GTOP = WS_GT + 8 * MiB, WS_GLAST = WS_GT + 16 * MiB;
constexpr size_t WS_END = 256 * MiB;
static_assert(WS_GT + (size_t)MP * DFF * 2 <= WS_END, "ws");
static_assert(WS_H + (size_t)MP * HW * 2 <= WS_BQ && WS_BQ + (size_t)MP * 256 * 4 <= WS_MIX && WS_MIX + (size_t)MP * 1024 * 2 <= WS_QT && WS_QT + (size_t)MP * 512 <= WS_KT && WS_KT + (size_t)MP * 512 <= WS_DS, "ws2");
static_assert(WS_DS + (size_t)257 * 4 * 8192 * 4 <= WS_SC && WS_SC + (size_t)256 * 4 * 8192 * 2 <= WS_GE && WS_GE + 257 * 256 * 4 <= WS_END, "ws3");
static_assert(WS_XB + (size_t)MP * 1024 * 2 <= WS_XTAIL && WS_XTAIL + 768 * 4096 <= WS_SH && WS_WDN + (size_t)1024 * DFF * 2 <= WS_XB, "ws4");
constexpr int LDS_BYTES = 147456;

__device__ __forceinline__ int opaque_tid() { int t = threadIdx.x; asm volatile("" : "+v"(t)); return t; }
__device__ __forceinline__ unsigned f2bf(float f) { unsigned u = __builtin_bit_cast(unsigned, f); return (u + 0x7fffu + ((u >> 16) & 1u)) >> 16; }
__device__ __forceinline__ unsigned pk2(float lo, float hi) { unsigned r; asm("v_cvt_pk_bf16_f32 %0, %1, %2" : "=v"(r) : "v"(lo), "v"(hi)); return r; }
__device__ __forceinline__ float bf2f(bf16 b) { return __builtin_bit_cast(float, (unsigned)b << 16); }
__device__ __forceinline__ float bflo(unsigned w) { return __builtin_bit_cast(float, w << 16); }
__device__ __forceinline__ float bfhi(unsigned w) { return __builtin_bit_cast(float, w & 0xffff0000u); }
__device__ __forceinline__ float wave_sum(float v) {
#pragma unroll
    for (int o = 1; o < 64; o <<= 1) v += __shfl_xor(v, o);
    return v;
}
__device__ __forceinline__ float silu_f(float x) { return x / (1.f + __expf(-x)); }
__device__ __forceinline__ int crow(int reg, int h) { return (reg & 3) + 8 * (reg >> 2) + 4 * h; }
#define MFMA32(a, b, c) __builtin_amdgcn_mfma_f32_32x32x16_bf16((a), (b), (c), 0, 0, 0)

struct Args { const float* in[22]; float* out; unsigned char* ws; };
struct Ctx { const __attribute__((address_space(4))) Args* ka; float* out; unsigned char* ws; };
#define CIN(i) (C.ka->in[i])

__device__ __forceinline__ void tr_item(const float* W, int ldw, int k0, int n0, bf16* WT, int ldt, int dstrow0, LAS float* scr, int lane) {
#pragma unroll
    for (int i = 0; i < 32; ++i) { const int kk = 2 * i + (lane >> 5); scr[kk * 33 + (lane & 31)] = W[(size_t)(k0 + kk) * ldw + n0 + (lane & 31)]; }
    asm volatile("s_waitcnt lgkmcnt(0)" ::: "memory");
    const int c = lane & 7;
#pragma unroll
    for (int j = 0; j < 4; ++j) { const int n = (lane >> 3) + 8 * j; const LAS float* s = scr + (8 * c) * 33 + n;
        u32x4 o; o.x = pk2(s[0 * 33], s[1 * 33]); o.y = pk2(s[2 * 33], s[3 * 33]); o.z = pk2(s[4 * 33], s[5 * 33]); o.w = pk2(s[6 * 33], s[7 * 33]);
        *(u32x4*)(WT + (size_t)(dstrow0 + n0 + n) * ldt + k0 + 8 * c) = o; }
    asm volatile("s_waitcnt lgkmcnt(0)" ::: "memory");
}
__device__ __forceinline__ void convert_weights(const Ctx& C, int l, LAS unsigned char* lds, const int part, const int wg0, const int nwg) {
    const int bidr = (int)blockIdx.x - wg0;
    if (bidr < 0 || bidr >= nwg) return;
    const int tid = opaque_tid(), lane = tid & 63, wave = tid >> 6;
    LAS float* scr = (LAS float*)(lds + wave * 16384);
    const int gw = bidr * 8 + wave, NGW = nwg * 8;
    unsigned char* ws = C.ws;
    const float* w_in = CIN(6) + (size_t)l * DM * DIN; const float* w_out = CIN(12) + (size_t)l * DM * DM;
    const float* w_up = CIN(15) + (size_t)l * DM * DFF; const float* w_gate = CIN(16) + (size_t)l * DM * DFF; const float* w_down = CIN(19) + (size_t)l * DFF * DM;
    const float* w_pool = CIN(9) + (size_t)l * 4 * 128 * 128;
    constexpr int I_IN = 16 * 64, I_OUT = 16 * 32, I_UP = 16 * 88, I_DN = 44 * 32, I_PL = 4 * 2 * 4;
    if (part == 0 || part == 1) {
        for (int it = gw; it < I_IN + I_OUT + I_PL; it += NGW) {
            int r = it;
            if (r < I_IN) { tr_item(w_in, DIN, 64 * (r / 64), 32 * (r % 64), (bf16*)(ws + WS_WIN), 1024, 0, scr, lane); continue; } r -= I_IN;
            if (r < I_OUT) { tr_item(w_out, DM, 64 * (r / 32), 32 * (r % 32), (bf16*)(ws + WS_WOUT), 1024, 0, scr, lane); continue; } r -= I_OUT;
            { const int g = r >> 3, q = r & 7; tr_item(w_pool + (size_t)g * 16384, 128, 64 * (q >> 2), 32 * (q & 3), (bf16*)(ws + WS_WPOOL) + (size_t)g * 16384, 128, 0, scr, lane); }
        }
        bf16* WZ = (bf16*)(ws + WS_WZ);
        for (int i = bidr * 512 + tid; i < 16 * 1024; i += nwg * 512) { const int n = i >> 10, k = i & 1023; WZ[i] = (bf16)f2bf(w_in[(size_t)k * DIN + 2048 + n]); }
    }
    if (part == 0 || part == 2) {
        for (int it = gw; it < 2 * I_UP; it += NGW) {
            int r = it;
            if (r < I_UP) { const int n0 = 32 * (r % 88); tr_item(w_up, DFF, 64 * (r / 88), n0, (bf16*)(ws + WS_WUG), 1024, (n0 >> 7) * 256 + (n0 & 127) - n0, scr, lane); continue; } r -= I_UP;
            { const int n0 = 32 * (r % 88); tr_item(w_gate, DFF, 64 * (r / 88), n0, (bf16*)(ws + WS_WUG), 1024, (n0 >> 7) * 256 + 128 + (n0 & 127) - n0, scr, lane); }
        }
    }
    if (part == 0 || part == 3) {
        for (int r = gw; r < I_DN; r += NGW) tr_item(w_down, DM, 64 * (r / 32), 32 * (r % 32), (bf16*)(ws + WS_WDN), DFF, 0, scr, lane);
    }
}
__device__ __forceinline__ void build_x(const Ctx& C) {
    const int tid = opaque_tid(), lane = tid & 63, wave = tid >> 6;
    const int gw = blockIdx.x * 8 + wave, NGW = gridDim.x * 8;
    bf16* XB = (bf16*)(C.ws + WS_XB);
    for (int row = gw; row < MP; row += NGW) {
        const float* src = nullptr;
        if (row < R_META) src = CIN(0) + (size_t)row * 1024; else if (row < R_SAMP) src = CIN(5) + (size_t)(row - R_META) * 1024; else if (row < M_REAL) src = CIN(1) + (size_t)(row - R_SAMP) * 1024;
#pragma unroll
        for (int j = 0; j < 4; ++j) {
            f32x4 v = src ? *((const f32x4*)src + lane + 64 * j) : (f32x4){0.f, 0.f, 0.f, 0.f};
            u32x2 o; o.x = pk2(v.x, v.y); o.y = pk2(v.z, v.w);
            *((u32x2*)(XB + (size_t)row * 1024) + lane + 64 * j) = o;
        }
    }
}
__device__ __forceinline__ void ln_phase(const Ctx& C, const float* g, const float* b, bool final) {
    const int tid = opaque_tid(), lane = tid & 63, wave = tid >> 6;
    const int gw = blockIdx.x * 8 + wave, NGW = gridDim.x * 8;
    bf16* XB = (bf16*)(C.ws + WS_XB); float* XT = (float*)(C.ws + WS_XTAIL);
    f32x4 gv[4], bv[4];
#pragma unroll
    for (int j = 0; j < 4; ++j) { gv[j] = *((const f32x4*)g + 4 * lane + j); bv[j] = *((const f32x4*)b + 4 * lane + j); }
#pragma unroll 2
    for (int row = gw; row < M_REAL; row += NGW) {
        f32x4 v[4]; float s = 0.f;
        float* xr = row < R_META ? C.out + O_YP + (size_t)row * 1024 : XT + (size_t)(row - R_META) * 1024;
        {
            const u32x4 w0 = *((const u32x4*)(XB + (size_t)row * 1024) + 2 * lane), w1 = *((const u32x4*)(XB + (size_t)row * 1024) + 2 * lane + 1);
            v[0] = (f32x4){bflo(w0.x), bfhi(w0.x), bflo(w0.y), bfhi(w0.y)}; v[1] = (f32x4){bflo(w0.z), bfhi(w0.z), bflo(w0.w), bfhi(w0.w)};
            v[2] = (f32x4){bflo(w1.x), bfhi(w1.x), bflo(w1.y), bfhi(w1.y)}; v[3] = (f32x4){bflo(w1.z), bfhi(w1.z), bflo(w1.w), bfhi(w1.w)};
        }
#pragma unroll
        for (int j = 0; j < 4; ++j) s += (v[j].x + v[j].y) + (v[j].z + v[j].w);
        const float mean = wave_sum(s) * (1.f / 1024.f); float s2 = 0.f;
#pragma unroll
        for (int j = 0; j < 4; ++j) { v[j] = v[j] - mean; s2 += (v[j].x * v[j].x + v[j].y * v[j].y) + (v[j].z * v[j].z + v[j].w * v[j].w); }
        const float rstd = 1.f / sqrtf(wave_sum(s2) * (1.f / 1024.f) + 1e-5f);
#pragma unroll
        for (int j = 0; j < 4; ++j) v[j] = v[j] * rstd * gv[j] + bv[j];
        if (final) {
#pragma unroll
            for (int j = 0; j < 4; ++j) { if (row < R_META) *((f32x4*)xr + 4 * lane + j) = v[j]; else if (row >= R_SAMP) *((f32x4*)(C.out + O_YS + (size_t)(row - R_SAMP) * 1024) + 4 * lane + j) = v[j]; }
        } else {
            u32x4 o0, o1; o0.x = pk2(v[0].x, v[0].y); o0.y = pk2(v[0].z, v[0].w); o0.z = pk2(v[1].x, v[1].y); o0.w = pk2(v[1].z, v[1].w);
            o1.x = pk2(v[2].x, v[2].y); o1.y = pk2(v[2].z, v[2].w); o1.z = pk2(v[3].x, v[3].y); o1.w = pk2(v[3].z, v[3].w);
            *((u32x4*)(XB + (size_t)row * 1024) + 2 * lane) = o0; *((u32x4*)(XB + (size_t)row * 1024) + 2 * lane + 1) = o1;
        }
    }
}
__device__ __forceinline__ void unpack8(const u32x4 w, float (&f)[8]) { f[0] = bflo(w.x); f[1] = bfhi(w.x); f[2] = bflo(w.y); f[3] = bfhi(w.y); f[4] = bflo(w.z); f[5] = bfhi(w.z); f[6] = bflo(w.w); f[7] = bfhi(w.w); }
__device__ __forceinline__ void conv_phase(const Ctx& C, int l) {
    bf16* AUP = (bf16*)(C.ws + WS_AUP); const bf16* GT = (const bf16*)(C.ws + WS_GTT) - (size_t)16384 * DFF;
    const float* cw = CIN(17) + (size_t)l * 3 * DFF; const float* cb = CIN(18) + (size_t)l * DFF;
    const int nthr = gridDim.x * 512;
    for (int id = blockIdx.x * 512 + opaque_tid(); id < 132 * 352; id += nthr) {
        const int q = id / 352, c0 = (id - q * 352) * 8, row0 = R_META + 4 * q;
        float p2[8], p1[8];
        if (q >= 4) { const int sb = q - 4; const float* sc = CIN(4) + ((size_t)(l * NSB + sb) * 2) * DFF + c0;
#pragma unroll
            for (int j = 0; j < 8; ++j) { p2[j] = sc[j]; p1[j] = sc[DFF + j]; } }
        else if (q > 0) { unpack8(*(const u32x4*)(GT + (size_t)(row0 - 2) * DFF + c0), p2); unpack8(*(const u32x4*)(GT + (size_t)(row0 - 1) * DFF + c0), p1); }
        else {
#pragma unroll
            for (int j = 0; j < 8; ++j) { p2[j] = 0.f; p1[j] = 0.f; } }
        u32x4 gtr[4], ar[4];
#pragma unroll
        for (int r = 0; r < 4; ++r) { gtr[r] = *(const u32x4*)(GT + (size_t)(row0 + r) * DFF + c0); ar[r] = *(const u32x4*)(AUP + (size_t)(row0 + r) * DFF + c0); }
        float w0[8], w1[8], w2[8], bb[8];
#pragma unroll
        for (int j = 0; j < 8; ++j) { w0[j] = cw[c0 + j]; w1[j] = cw[DFF + c0 + j]; w2[j] = cw[2 * DFF + c0 + j]; bb[j] = cb[c0 + j]; }
#pragma unroll
        for (int r = 0; r < 4; ++r) {
            float cur[8], a[8], gq[8]; unpack8(gtr[r], cur); unpack8(ar[r], a);
#pragma unroll
            for (int j = 0; j < 8; ++j) { const float gc = bb[j] + w0[j] * p2[j] + w1[j] * p1[j] + w2[j] * cur[j]; gq[j] = a[j] * silu_f(gc); }
            u32x4 o; o.x = pk2(gq[0], gq[1]); o.y = pk2(gq[2], gq[3]); o.z = pk2(gq[4], gq[5]); o.w = pk2(gq[6], gq[7]);
            *(u32x4*)(AUP + (size_t)(row0 + r) * DFF + c0) = o;
            if (q >= 4 && r >= 2) { float* od = C.out + O_CS + ((size_t)(l * NSB + (q - 4)) * 2 + (r - 2)) * DFF + c0;
                *(f32x4*)od = (f32x4){cur[0], cur[1], cur[2], cur[3]}; *(f32x4*)(od + 4) = (f32x4){cur[4], cur[5], cur[6], cur[7]}; }
#pragma unroll
            for (int j = 0; j < 8; ++j) { p2[j] = p1[j]; p1[j] = cur[j]; }
        }
    }
    const bf16* GTOP = (const bf16*)(C.ws + WS_GTOP); const bf16* GLAST = (const bf16*)(C.ws + WS_GLAST);
    for (int id = blockIdx.x * 512 + opaque_tid(); id < 256 * 2 * 352; id += nthr) {
        const int S = id / 704, rr = (id / 352) & 1, c0 = (id % 352) * 8, row = 64 * S + rr, t = row & 2047;
        float p2[8], p1[8], cur[8], a[8];
        if (rr == 0) {
            unpack8(*(const u32x4*)(t == 0 ? GT + (size_t)(R_META + 14) * DFF + c0 : GLAST + (size_t)((S - 1) * 2) * DFF + c0), p2);
            unpack8(*(const u32x4*)(t == 0 ? GT + (size_t)(R_META + 15) * DFF + c0 : GLAST + (size_t)((S - 1) * 2 + 1) * DFF + c0), p1);
        } else {
            unpack8(*(const u32x4*)(t == 1 ? GT + (size_t)(R_META + 15) * DFF + c0 : GLAST + (size_t)((S - 1) * 2 + 1) * DFF + c0), p2);
            unpack8(*(const u32x4*)(GTOP + (size_t)(S * 2) * DFF + c0), p1);
        }
        unpack8(*(const u32x4*)(GTOP + (size_t)(S * 2 + rr) * DFF + c0), cur); unpack8(*(const u32x4*)(AUP + (size_t)row * DFF + c0), a);
        float gq[8];
#pragma unroll
        for (int j = 0; j < 8; ++j) { const float gc = cb[c0 + j] + cw[c0 + j] * p2[j] + cw[DFF + c0 + j] * p1[j] + cw[2 * DFF + c0 + j] * cur[j]; gq[j] = a[j] * silu_f(gc); }
        u32x4 o; o.x = pk2(gq[0], gq[1]); o.y = pk2(gq[2], gq[3]); o.z = pk2(gq[4], gq[5]); o.w = pk2(gq[6], gq[7]);
        *(u32x4*)(AUP + (size_t)row * DFF + c0) = o;
    }
    for (int id = blockIdx.x * 512 + opaque_tid(); id < NB * 2 * 352; id += nthr) {
        const int b = id / 704, j = (id / 352) & 1, c0 = (id % 352) * 8;
        float cur[8]; unpack8(*(const u32x4*)(GLAST + (size_t)((32 * b + 31) * 2 + j) * DFF + c0), cur);
        float* od = C.out + O_CP + ((size_t)(l * NB + b) * 2 + j) * DFF + c0;
        *(f32x4*)od = (f32x4){cur[0], cur[1], cur[2], cur[3]}; *(f32x4*)(od + 4) = (f32x4){cur[4], cur[5], cur[6], cur[7]};
    }
}
__device__ __forceinline__ void fill_vt(const bf16* H, int row0, int CN, LAS bf16* VT, int tid) {
    const int sp = tid & 31, s = 2 * sp, cc0 = tid >> 5;
    u32x4 v0[4], v1[4];
#pragma unroll
    for (int it = 0; it < 4; ++it) {
        const int c0 = 8 * (cc0 + 16 * it);
        v0[it] = s < CN ? *(const u32x4*)(H + (size_t)(row0 + s) * HW + HC_V + c0) : (u32x4){0u, 0u, 0u, 0u};
        v1[it] = (s + 1) < CN ? *(const u32x4*)(H + (size_t)(row0 + s + 1) * HW + HC_V + c0) : (u32x4){0u, 0u, 0u, 0u};
    }
#pragma unroll
    for (int it = 0; it < 4; ++it) {
        const int c0 = 8 * (cc0 + 16 * it);
#pragma unroll
        for (int e = 0; e < 4; ++e) {
            const unsigned a = v0[it][e], b = v1[it][e];
            *(LAS unsigned*)(VT + (c0 + 2 * e) * 72 + s) = (a & 0xffffu) | (b << 16);
            *(LAS unsigned*)(VT + (c0 + 2 * e + 1) * 72 + s) = (a >> 16) | (b & 0xffff0000u);
        }
    }
}
__device__ __forceinline__ void mixA_tile(const Ctx& C, int l, int tile, LAS unsigned char* lds, const int mode, const int hfsel = -1) {
    const int tid = opaque_tid(), lane = tid & 63, wave = __builtin_amdgcn_readfirstlane(tid >> 6), half = lane >> 5, l32 = lane & 31;
    const int kind = tile < 256 ? 0 : (tile == 256 ? 1 : 2);
    const int row0 = kind == 0 ? tile * 64 : (kind == 1 ? R_META : R_SAMP + 64 * (tile - 257));
    const int CN = kind == 1 ? 16 : 64;
    const bf16* XB = (const bf16*)(C.ws + WS_XB); const bf16* H = (const bf16*)(C.ws + WS_H); const bf16* WZ = (const bf16*)(C.ws + WS_WZ); const bf16* WPOOL = (const bf16*)(C.ws + WS_WPOOL);
    bf16* QT = (bf16*)(C.ws + WS_QT); bf16* KT = (bf16*)(C.ws + WS_KT); bf16* MIX = (bf16*)(C.ws + WS_MIX);
    bf16* DS = (bf16*)(C.ws + WS_DS); float* GE = (float*)(C.ws + WS_GE);
    LAS float* ZR = (LAS float*)lds;
    LAS bf16* KDT = (LAS bf16*)(lds + 8192);
    LAS float* BL = (LAS float*)(lds + 45056);
    LAS bf16* VT = (LAS bf16*)(lds + 45056);
    LAS bf16* US = (LAS bf16*)lds;
    LAS bf16* DP = (LAS bf16*)(lds + 40448);
    if (mode != 2) {
    u32x4 q0[2], q1[2], k0[2], k1[2], pv0[4], pv1[4];
    {
        const int sp = tid & 31, s = 2 * sp, cc0 = tid >> 5;
#pragma unroll
        for (int it = 0; it < 2; ++it) {
            const int c0 = 8 * (cc0 + 16 * it);
            const bf16* hp = H + (size_t)(row0 + s) * HW + c0;
            q0[it] = *(const u32x4*)(hp + HC_Q); q1[it] = *(const u32x4*)(hp + HW + HC_Q); k0[it] = *(const u32x4*)(hp + HC_K); k1[it] = *(const u32x4*)(hp + HW + HC_K);
        }
#pragma unroll
        for (int it = 0; it < 4; ++it) {
            const int c0 = 8 * (cc0 + 16 * it);
            pv0[it] = s < CN ? *(const u32x4*)(H + (size_t)(row0 + s) * HW + HC_V + c0) : (u32x4){0u, 0u, 0u, 0u};
            pv1[it] = (s + 1) < CN ? *(const u32x4*)(H + (size_t)(row0 + s + 1) * HW + HC_V + c0) : (u32x4){0u, 0u, 0u, 0u};
        }
    }
    {
        const int rt = wave & 3, kh = wave >> 2, fr = lane & 15, fq = lane >> 4;
        if (16 * rt < CN) {
        const bf16* xa = XB + (size_t)(row0 + 16 * rt + fr) * 1024 + kh * 512 + 8 * fq;
        const bf16* wz = WZ + (size_t)fr * 1024 + kh * 512 + 8 * fq;
        f32x4 acc = (f32x4){0.f, 0.f, 0.f, 0.f};
#pragma unroll 8
        for (int s = 0; s < 16; ++s) { const bf16x8 a = *(const bf16x8*)(wz + 32 * s); const bf16x8 b = *(const bf16x8*)(xa + 32 * s); acc = __builtin_amdgcn_mfma_f32_16x16x32_bf16(a, b, acc, 0, 0, 0); }
        *(LAS f32x4*)(ZR + (kh * 64 + 16 * rt + fr) * 20 + 4 * fq) = acc;
        }
    }
    __syncthreads();
    {
        const float* wa_g = CIN(7) + (size_t)l * 16 * 256;
        const int colz = 32 * wave + l32;
        f32x16 zacc[2];
#pragma unroll
        for (int tm = 0; tm < 2; ++tm)
#pragma unroll
            for (int i = 0; i < 16; ++i) zacc[tm][i] = 0.f;
#pragma unroll
        for (int ks = 0; ks < 8; ++ks) {
            const float bw = wa_g[(2 * ks + half) * 256 + colz];
#pragma unroll
            for (int tm = 0; tm < 2; ++tm)
#pragma unroll
                for (int kh = 0; kh < 2; ++kh) zacc[tm] = __builtin_amdgcn_mfma_f32_32x32x2f32(ZR[(kh * 64 + 32 * tm + l32) * 20 + 2 * ks + half], bw, zacc[tm], 0, 0, 0);
        }
        const float ba = CIN(8)[l * 256 + colz];
#pragma unroll
        for (int tm = 0; tm < 2; ++tm)
#pragma unroll
            for (int i = 0; i < 16; ++i) {
                const float z = zacc[tm][i] + ba;
                BL[(32 * tm + crow(i, half)) * 260 + colz] = (fminf(z, 0.f) - __logf(1.f + __expf(-fabsf(z)))) * (1.f / 16.f);
            }
    }
    __syncthreads();
    {
        const int col = tid & 255, th = tid >> 8;
        const int ntt = (CN - th * 32) < 32 ? ((CN - th * 32) > 0 ? (CN - th * 32) : 0) : 32;
        float bc = 0.f;
#pragma unroll 8
        for (int tt = 0; tt < ntt; ++tt) {
            const int t = th * 32 + tt;
            if (kind == 2 && (tt & 3) == 0) bc = 0.f;
            bc += BL[t * 260 + col];
            BL[t * 260 + col] = bc;
        }
    }
    __syncthreads();
    {
        const int sp = tid & 31, s = 2 * sp, cc0 = tid >> 5;
        const bool addoff = (kind != 2) && (s >= 32);
#pragma unroll
        for (int it = 0; it < 2; ++it) {
            const int c0 = 8 * (cc0 + 16 * it);
            float b0[8], b1[8], be[8], off[8];
#pragma unroll
            for (int e = 0; e < 2; ++e) {
                const f32x4 x0 = *(const LAS f32x4*)(BL + s * 260 + c0 + 4 * e), x1 = *(const LAS f32x4*)(BL + (s + 1) * 260 + c0 + 4 * e);
                const f32x4 o31 = *(const LAS f32x4*)(BL + 31 * 260 + c0 + 4 * e), oe = *(const LAS f32x4*)(BL + (CN - 1) * 260 + c0 + 4 * e);
#pragma unroll
                for (int j = 0; j < 4; ++j) { off[4 * e + j] = addoff ? o31[j] : 0.f; b0[4 * e + j] = x0[j] + off[4 * e + j]; b1[4 * e + j] = x1[j] + off[4 * e + j]; be[4 * e + j] = oe[j] + (CN == 64 ? o31[j] : 0.f); }
            }
            float qf0[8], qf1[8], kf0[8], kf1[8];
            unpack8(q0[it], qf0); unpack8(q1[it], qf1); unpack8(k0[it], kf0); unpack8(k1[it], kf1);
            float e0[8], e1[8];
#pragma unroll
            for (int j = 0; j < 8; ++j) { e0[j] = __expf(b0[j]); e1[j] = __expf(b1[j]); }
            float r0[8], r1[8];
#pragma unroll
            for (int j = 0; j < 8; ++j) { r0[j] = __builtin_amdgcn_rcpf(e0[j]); r1[j] = __builtin_amdgcn_rcpf(e1[j]); }
            if (s < CN) {
                const size_t r = (size_t)(row0 + s);
                u32x4 o;
                o.x = pk2(qf0[0] * 0.125f * e0[0], qf0[1] * 0.125f * e0[1]); o.y = pk2(qf0[2] * 0.125f * e0[2], qf0[3] * 0.125f * e0[3]); o.z = pk2(qf0[4] * 0.125f * e0[4], qf0[5] * 0.125f * e0[5]); o.w = pk2(qf0[6] * 0.125f * e0[6], qf0[7] * 0.125f * e0[7]);
                *(u32x4*)(QT + r * 256 + c0) = o;
                o.x = pk2(qf1[0] * 0.125f * e1[0], qf1[1] * 0.125f * e1[1]); o.y = pk2(qf1[2] * 0.125f * e1[2], qf1[3] * 0.125f * e1[3]); o.z = pk2(qf1[4] * 0.125f * e1[4], qf1[5] * 0.125f * e1[5]); o.w = pk2(qf1[6] * 0.125f * e1[6], qf1[7] * 0.125f * e1[7]);
                *(u32x4*)(QT + (r + 1) * 256 + c0) = o;
                o.x = pk2(kf0[0] * r0[0], kf0[1] * r0[1]); o.y = pk2(kf0[2] * r0[2], kf0[3] * r0[3]); o.z = pk2(kf0[4] * r0[4], kf0[5] * r0[5]); o.w = pk2(kf0[6] * r0[6], kf0[7] * r0[7]);
                *(u32x4*)(KT + r * 256 + c0) = o;
                o.x = pk2(kf1[0] * r1[0], kf1[1] * r1[1]); o.y = pk2(kf1[2] * r1[2], kf1[3] * r1[3]); o.z = pk2(kf1[4] * r1[4], kf1[5] * r1[5]); o.w = pk2(kf1[6] * r1[6], kf1[7] * r1[7]);
                *(u32x4*)(KT + (r + 1) * 256 + c0) = o;
            }
            if (kind != 2) {
#pragma unroll
                for (int j = 0; j < 8; ++j) {
                    const float d0 = s < CN ? kf0[j] * __expf(be[j] - b0[j]) : 0.f, d1 = s < CN ? kf1[j] * __expf(be[j] - b1[j]) : 0.f;
                    *(LAS unsigned*)(KDT + (c0 + j) * 72 + s) = pk2(d0, d1);
                }
                if (s == 0) { *(f32x4*)(GE + tile * 256 + c0) = (f32x4){__expf(be[0]), __expf(be[1]), __expf(be[2]), __expf(be[3])}; *(f32x4*)(GE + tile * 256 + c0 + 4) = (f32x4){__expf(be[4]), __expf(be[5]), __expf(be[6]), __expf(be[7])}; }
            }
        }
    }
    __syncthreads();
    if (kind != 2) {
        {
            const int sp = tid & 31, s = 2 * sp, cc0 = tid >> 5;
#pragma unroll
            for (int it = 0; it < 4; ++it) {
                const int c0 = 8 * (cc0 + 16 * it);
#pragma unroll
                for (int e = 0; e < 4; ++e) {
                    const unsigned a = pv0[it][e], b = pv1[it][e];
                    *(LAS unsigned*)(VT + (c0 + 2 * e) * 72 + s) = (a & 0xffffu) | (b << 16);
                    *(LAS unsigned*)(VT + (c0 + 2 * e + 1) * 72 + s) = (a >> 16) | (b & 0xffff0000u);
                }
            }
        }
        __syncthreads();
        {
            const int h = wave >> 1, dvh = wave & 1;
#pragma unroll
            for (int mt = 0; mt < 2; ++mt)
#pragma unroll
                for (int nt = 0; nt < 2; ++nt) {
                    f32x16 acc;
#pragma unroll
                    for (int i = 0; i < 16; ++i) acc[i] = 0.f;
#pragma unroll
                    for (int ks = 0; ks < 4; ++ks) {
                        const bf16x8 a = *(const LAS bf16x8*)(VT + (h * 128 + dvh * 64 + mt * 32 + l32) * 72 + 16 * ks + 8 * half);
                        const bf16x8 b = *(const LAS bf16x8*)(KDT + (h * 64 + nt * 32 + l32) * 72 + 16 * ks + 8 * half);
                        acc = MFMA32(a, b, acc);
                    }
                    bf16* dp = DS + ((size_t)(tile * 4 + h) * 128 + dvh * 64 + mt * 32) * 64 + nt * 32 + l32;
#pragma unroll
                    for (int i = 0; i < 16; ++i) dp[crow(i, half) * 64] = (bf16)f2bf(acc[i]);
                }
        }
        __syncthreads();
    }
    }
    if (mode == 1) return;
#pragma unroll 1
    for (int hf = (hfsel < 0 ? 0 : hfsel); hf < (hfsel < 0 ? 2 : hfsel + 1); ++hf) {
        const int c = tid & 255, th = tid >> 8, g = 2 * hf + (c >> 7), w = 2 << g; const float invw = 1.f / (float)w;
        if (kind != 2) {
            u32x4 v[5];
#pragma unroll
            for (int i = 0; i < 5; ++i) {
                const int idx = tid + 512 * i, p = idx >> 5, ch = idx & 31, t = p - 15;
                int row = -1;
                if (p < 79) {
                    if (kind == 0) { const int tg = (tile & 31) * 64 + t; row = tg >= 0 ? (tile >> 5) * 2048 + tg : R_META + 16 + tg; }
                    else if (t >= 0 && t < 16) row = R_META + t;
                }
                v[i] = row >= 0 ? *(const u32x4*)(H + (size_t)row * HW + 256 * hf + 8 * ch) : (u32x4){0u, 0u, 0u, 0u};
            }
#pragma unroll
            for (int i = 0; i < 5; ++i) { const int idx = tid + 512 * i, p = idx >> 5, ch = idx & 31; if (p < 79) *(LAS u32x4*)(US + p * 256 + 8 * ch) = v[i]; }
            __syncthreads();
            const int tb = th * 32;
            float s = 0.f;
            for (int j = 1; j < w; ++j) s += bf2f(US[(15 + tb - j) * 256 + c]);
            const bool last = kind == 0 && (tile & 31) == 31;
#pragma unroll 4
            for (int tt = 0; tt < 32; ++tt) {
                const int t = tb + tt;
                const float u = bf2f(US[(15 + t) * 256 + c]); s += u;
                float d;
                if (kind == 0) d = s * invw - u; else { const int cnt = (t + 1) < w ? (t + 1) : w; d = s / (float)cnt - u; }
                DP[t * 264 + c] = (bf16)f2bf(d);
                s -= bf2f(US[(15 + t - w + 1) * 256 + c]);
                if (last && t >= 49) C.out[O_PP + ((size_t)(l * NB + (tile >> 5)) * 15 + (t - 49)) * 512 + 256 * hf + c] = u;
            }
        } else {
            const int cg = 256 * hf + c;
#pragma unroll 2
            for (int qq = 0; qq < 8; ++qq) {
                const int q = th * 8 + qq, sb = (tile - 257) * 16 + q, r0 = row0 + 4 * q;
                const float* pv = CIN(2) + ((size_t)(l * NSB + sb) * 15) * 512 + cg;
                float* po = C.out + O_PS + ((size_t)(l * NSB + sb) * 15) * 512 + cg;
                float pr[15], u[4];
#pragma unroll
                for (int j = 0; j < 15; ++j) pr[j] = pv[j * 512];
#pragma unroll
                for (int t = 0; t < 4; ++t) u[t] = bf2f(H[(size_t)(r0 + t) * HW + cg]);
#pragma unroll
                for (int j = 0; j < 11; ++j) po[j * 512] = pr[4 + j];
#pragma unroll
                for (int t = 0; t < 4; ++t) po[(11 + t) * 512] = u[t];
#pragma unroll
                for (int t = 0; t < 4; ++t) {
                    float s = 0.f;
#pragma unroll
                    for (int i = 0; i < 19; ++i) { const float fv = i < 15 ? pr[i < 15 ? i : 0] : u[i >= 15 ? i - 15 : 0]; s += (i <= 15 + t && i > 15 + t - w) ? fv : 0.f; }
                    DP[(4 * q + t) * 264 + c] = (bf16)f2bf(s * invw - u[t]);
                }
            }
        }
        __syncthreads();
        {
            const int gl = wave >> 2, qn = wave & 3, gg = 2 * hf + gl;
            const bf16* WP = WPOOL + (size_t)gg * 16384;
            f32x16 acc[2];
#pragma unroll
            for (int b = 0; b < 2; ++b)
#pragma unroll
                for (int i = 0; i < 16; ++i) acc[b][i] = 0.f;
#pragma unroll
            for (int ks = 0; ks < 8; ++ks) {
                const bf16x8 a = *(const bf16x8*)(WP + (size_t)(32 * qn + l32) * 128 + 16 * ks + 8 * half);
#pragma unroll
                for (int tt = 0; tt < 2; ++tt) { const bf16x8 bb = *(const LAS bf16x8*)(DP + (32 * tt + l32) * 264 + gl * 128 + 16 * ks + 8 * half); acc[tt] = MFMA32(a, bb, acc[tt]); }
            }
#pragma unroll
            for (int tt = 0; tt < 2; ++tt) {
                const int t = 32 * tt + l32;
                if (t < CN) {
                    bf16* mp = MIX + (size_t)(row0 + t) * 1024 + gg * 128;
#pragma unroll
                    for (int i4 = 0; i4 < 4; ++i4) {
                        const int n0 = 32 * qn + 8 * i4 + 4 * half;
                        const f32x4 ps = *(const f32x4*)(CIN(10) + l * 512 + gg * 128 + n0);
                        u32x2 o; o.x = pk2(acc[tt][4 * i4] * ps.x, acc[tt][4 * i4 + 1] * ps.y); o.y = pk2(acc[tt][4 * i4 + 2] * ps.z, acc[tt][4 * i4 + 3] * ps.w);
                        *(u32x2*)(mp + n0) = o;
                    }
                }
            }
        }
        __syncthreads();
    }
}
__device__ __forceinline__ void scan_phase(const Ctx& C, int l) {
    const bf16* DS = (const bf16*)(C.ws + WS_DS); const float* GE = (const float*)(C.ws + WS_GE); bf16* SC = (bf16*)(C.ws + WS_SC);
    const int nthr = gridDim.x * 512;
    for (int e0 = blockIdx.x * 512 + opaque_tid(); e0 < 131072; e0 += nthr) {
        const int e1 = e0 + 131072;
        const int hd0 = e0 & 8191, h0 = (e0 >> 13) & 3, b0 = e0 >> 15, dk0 = e0 & 63, dv0 = (e0 >> 6) & 127;
        const int hd1 = e1 & 8191, h1 = (e1 >> 13) & 3, b1 = e1 >> 15, dk1 = e1 & 63, dv1 = (e1 >> 6) & 127;
        float S0 = bf2f(DS[((size_t)256 * 4 + h0) * 8192 + hd0]), S1 = bf2f(DS[((size_t)256 * 4 + h1) * 8192 + hd1]);
#pragma unroll 8
        for (int c = 0; c < 32; ++c) {
            const int ci0 = b0 * 32 + c, ci1 = b1 * 32 + c; const size_t o0 = ((size_t)ci0 * 4 + h0) * 8192 + hd0, o1 = ((size_t)ci1 * 4 + h1) * 8192 + hd1;
            SC[o0] = (bf16)f2bf(S0); SC[o1] = (bf16)f2bf(S1);
            S0 = GE[ci0 * 256 + h0 * 64 + dk0] * S0 + bf2f(DS[o0]); S1 = GE[ci1 * 256 + h1 * 64 + dk1] * S1 + bf2f(DS[o1]);
        }
        C.out[O_GP + ((size_t)((l * NB + b0) * 4 + h0) * 64 + dk0) * 128 + dv0] = S0;
        C.out[O_GP + ((size_t)((l * NB + b1) * 4 + h1) * 64 + dk1) * 128 + dv1] = S1;
    }
}
__device__ __forceinline__ void glaC_tile(const Ctx& C, int l, int tile, LAS unsigned char* lds) {
    const int tid = opaque_tid(), lane = tid & 63, wave = __builtin_amdgcn_readfirstlane(tid >> 6), half = lane >> 5, l32 = lane & 31;
    const int kind = tile < 256 ? 0 : 1;
    const int row0 = kind == 0 ? tile * 64 : R_META;
    const int CN = kind == 1 ? 16 : 64;
    const bf16* H = (const bf16*)(C.ws + WS_H); const bf16* QT = (const bf16*)(C.ws + WS_QT); const bf16* KT = (const bf16*)(C.ws + WS_KT); const bf16* SC = (const bf16*)(C.ws + WS_SC);
    bf16* MIX = (bf16*)(C.ws + WS_MIX);
    LAS bf16* VT = (LAS bf16*)lds;
    LAS bf16* P = (LAS bf16*)(lds + 73728);
    fill_vt(H, row0, CN, VT, tid);
    const int h = wave >> 1, th = wave & 1, T0 = 32 * th;
    bf16x8 QF[4];
#pragma unroll
    for (int ks = 0; ks < 4; ++ks) QF[ks] = *(const bf16x8*)(QT + (size_t)(row0 + T0 + l32) * 256 + h * 64 + 16 * ks + 8 * half);
    {
        const int t = T0 + l32;
        for (int sj = 0; sj <= th; ++sj) {
            f32x16 acc;
#pragma unroll
            for (int i = 0; i < 16; ++i) acc[i] = 0.f;
#pragma unroll
            for (int ks = 0; ks < 4; ++ks) { const bf16x8 a = *(const bf16x8*)(KT + (size_t)(row0 + 32 * sj + l32) * 256 + h * 64 + 16 * ks + 8 * half); acc = MFMA32(a, QF[ks], acc); }
#pragma unroll
            for (int i4 = 0; i4 < 4; ++i4) {
                const int s0 = 32 * sj + 8 * i4 + 4 * half;
                const float v0 = (s0 <= t) ? acc[4 * i4] : 0.f, v1 = (s0 + 1 <= t) ? acc[4 * i4 + 1] : 0.f, v2 = (s0 + 2 <= t) ? acc[4 * i4 + 2] : 0.f, v3 = (s0 + 3 <= t) ? acc[4 * i4 + 3] : 0.f;
                u32x2 o; o.x = pk2(v0, v1); o.y = pk2(v2, v3);
                *(LAS u32x2*)(P + (h * 64 + t) * 72 + s0) = o;
            }
        }
    }
    __syncthreads();
    f32x16 o[4];
#pragma unroll
    for (int n = 0; n < 4; ++n)
#pragma unroll
        for (int i = 0; i < 16; ++i) o[n][i] = 0.f;
    const int nks = 2 * (th + 1);
    for (int ks = 0; ks < nks; ++ks) {
        const bf16x8 b = *(const LAS bf16x8*)(P + (h * 64 + T0 + l32) * 72 + 16 * ks + 8 * half);
#pragma unroll
        for (int n = 0; n < 4; ++n) { const bf16x8 a = *(const LAS bf16x8*)(VT + (h * 128 + 32 * n + l32) * 72 + 16 * ks + 8 * half); o[n] = MFMA32(a, b, o[n]); }
    }
    if (kind == 0) {
#pragma unroll
        for (int ks = 0; ks < 4; ++ks)
#pragma unroll
            for (int n = 0; n < 4; ++n) { const bf16x8 a = *(const bf16x8*)(SC + ((size_t)(tile * 4 + h) * 128 + 32 * n + l32) * 64 + 16 * ks + 8 * half); o[n] = MFMA32(a, QF[ks], o[n]); }
    }
    float ss = 0.f;
#pragma unroll
    for (int n = 0; n < 4; ++n)
#pragma unroll
        for (int i = 0; i < 16; ++i) ss += o[n][i] * o[n][i];
    ss += __shfl_xor(ss, 32);
    const float rinv = rsqrtf(ss * (1.f / 128.f) + 1e-6f);
    {
        const int t = T0 + l32;
        if (t < CN) {
            const size_t row = (size_t)(row0 + t);
#pragma unroll
            for (int n = 0; n < 4; ++n)
#pragma unroll
                for (int i4 = 0; i4 < 4; ++i4) {
                    const int dv0 = 32 * n + 8 * i4 + 4 * half;
                    const u32x2 rr = *(const u32x2*)(H + row * HW + HC_R + h * 128 + dv0);
                    const f32x4 gn = *(const f32x4*)(CIN(11) + l * 128 + dv0);
                    const float y0 = o[n][4 * i4] * rinv * gn.x * silu_f(bflo(rr.x)), y1 = o[n][4 * i4 + 1] * rinv * gn.y * silu_f(bfhi(rr.x));
                    const float y2 = o[n][4 * i4 + 2] * rinv * gn.z * silu_f(bflo(rr.y)), y3 = o[n][4 * i4 + 3] * rinv * gn.w * silu_f(bfhi(rr.y));
                    u32x2 ov; ov.x = pk2(y0, y1); ov.y = pk2(y2, y3);
                    *(u32x2*)(MIX + row * 1024 + 512 + h * 128 + dv0) = ov;
                }
        }
    }
    __syncthreads();
}
__device__ __forceinline__ void gla_sample_item(const Ctx& C, int l, int j, LAS unsigned char* lds) {
    const int tid = opaque_tid(), lane = tid & 63;
    const int sb = j >> 1, hp = j & 1, hl = tid >> 8, dh = (tid >> 7) & 1, dv = tid & 127, h = hp * 2 + hl;
    const int r0 = R_SAMP + sb * 4;
    const bf16* H = (const bf16*)(C.ws + WS_H); bf16* MIX = (bf16*)(C.ws + WS_MIX);
    LAS float* QS = (LAS float*)lds;
    LAS float* KD = QS + 512;
    LAS float* GEe = KD + 512;
    LAS float* AT = GEe + 128;
    LAS float* OP = AT + 32;
    LAS float* RS = OP + 2048;
    LAS float* ZRs = RS + 16;
    {
        const bf16* XBp = (const bf16*)(C.ws + WS_XB); const bf16* WZ = (const bf16*)(C.ws + WS_WZ);
        const int t = tid >> 7, jz = (tid >> 3) & 15, kp = tid & 7;
        const bf16* xp = XBp + (size_t)(r0 + t) * 1024 + kp * 128; const bf16* wp = WZ + (size_t)jz * 1024 + kp * 128;
        float acc = 0.f;
#pragma unroll 4
        for (int i = 0; i < 16; ++i) { float xf[8], wf[8]; unpack8(*(const u32x4*)(xp + 8 * i), xf); unpack8(*(const u32x4*)(wp + 8 * i), wf);
#pragma unroll
            for (int e = 0; e < 8; ++e) acc += xf[e] * wf[e]; }
        acc += __shfl_xor(acc, 1); acc += __shfl_xor(acc, 2); acc += __shfl_xor(acc, 4);
        if (kp == 0) ZRs[t * 16 + jz] = acc;
    }
    __syncthreads();
    if (tid < 128) {
        const int hq = tid >> 6, d = tid & 63, col = (hp * 2 + hq) * 64 + d;
        float b[4], q[4], k[4];
        {
            float wa[16];
#pragma unroll
            for (int jj = 0; jj < 16; ++jj) wa[jj] = CIN(7)[(size_t)(l * 16 + jj) * 256 + col];
            const float ba = CIN(8)[l * 256 + col];
            float bc = 0.f;
#pragma unroll
            for (int t = 0; t < 4; ++t) { float z = ba;
#pragma unroll
                for (int jj = 0; jj < 16; ++jj) z += ZRs[t * 16 + jj] * wa[jj];
                bc += (fminf(z, 0.f) - __logf(1.f + __expf(-fabsf(z)))) * (1.f / 16.f); b[t] = bc; }
        }

#pragma unroll
        for (int t = 0; t < 4; ++t) { q[t] = bf2f(H[(size_t)(r0 + t) * HW + HC_Q + col]) * 0.125f; k[t] = bf2f(H[(size_t)(r0 + t) * HW + HC_K + col]); }
#pragma unroll
        for (int t = 0; t < 4; ++t) { QS[(hq * 4 + t) * 64 + d] = q[t] * __expf(b[t]); KD[(hq * 4 + t) * 64 + d] = k[t] * __expf(b[3] - b[t]); }
        GEe[hq * 64 + d] = __expf(b[3]);
#pragma unroll
        for (int t = 0; t < 4; ++t)
#pragma unroll
            for (int s = 0; s < 4; ++s) {
                float p = (s <= t) ? q[t] * k[s] * __expf(b[t] - b[s]) : 0.f;
                p = wave_sum(p);
                if (d == 0) AT[(hq * 4 + t) * 4 + s] = p;
            }
    }
    __syncthreads();
    float v[4];
#pragma unroll
    for (int s = 0; s < 4; ++s) v[s] = bf2f(H[(size_t)(r0 + s) * HW + HC_V + h * 128 + dv]);
    {
        const float* S0 = CIN(3) + ((size_t)((l * NSB + sb) * 4 + h) * 64) * 128 + dv;
        float* SO = C.out + O_GS + ((size_t)((l * NSB + sb) * 4 + h) * 64) * 128 + dv;
        float o0 = 0.f, o1 = 0.f, o2 = 0.f, o3 = 0.f;
#pragma unroll 16
        for (int dd = 0; dd < 32; ++dd) {
            const int d = dh * 32 + dd;
            const float s0 = S0[(size_t)d * 128];
            o0 += QS[(hl * 4 + 0) * 64 + d] * s0; o1 += QS[(hl * 4 + 1) * 64 + d] * s0; o2 += QS[(hl * 4 + 2) * 64 + d] * s0; o3 += QS[(hl * 4 + 3) * 64 + d] * s0;
            const float sn = GEe[hl * 64 + d] * s0 + KD[(hl * 4 + 0) * 64 + d] * v[0] + KD[(hl * 4 + 1) * 64 + d] * v[1] + KD[(hl * 4 + 2) * 64 + d] * v[2] + KD[(hl * 4 + 3) * 64 + d] * v[3];
            SO[(size_t)d * 128] = sn;
        }
        OP[((hl * 2 + dh) * 4 + 0) * 128 + dv] = o0; OP[((hl * 2 + dh) * 4 + 1) * 128 + dv] = o1; OP[((hl * 2 + dh) * 4 + 2) * 128 + dv] = o2; OP[((hl * 2 + dh) * 4 + 3) * 128 + dv] = o3;
    }
    __syncthreads();
    float oo[2];
#pragma unroll
    for (int e = 0; e < 2; ++e) {
        const int t = 2 * dh + e;
        float o = OP[((hl * 2 + 0) * 4 + t) * 128 + dv] + OP[((hl * 2 + 1) * 4 + t) * 128 + dv];
#pragma unroll
        for (int s = 0; s < 4; ++s) o += (s <= t) ? AT[(hl * 4 + t) * 4 + s] * v[s] : 0.f;
        oo[e] = o;
        const float ssq = wave_sum(o * o);
        if (lane == 0) RS[(hl * 4 + t) * 2 + ((tid >> 6) & 1)] = ssq;
    }
    __syncthreads();
#pragma unroll
    for (int e = 0; e < 2; ++e) {
        const int t = 2 * dh + e;
        const float tot = RS[(hl * 4 + t) * 2] + RS[(hl * 4 + t) * 2 + 1];
        const float rinv = rsqrtf(tot * (1.f / 128.f) + 1e-6f);
        const float r = bf2f(H[(size_t)(r0 + t) * HW + HC_R + h * 128 + dv]);
        MIX[(size_t)(r0 + t) * 1024 + 512 + h * 128 + dv] = (bf16)f2bf(oo[e] * rinv * CIN(11)[l * 128 + dv] * silu_f(r));
    }
    __syncthreads();
}
struct MiniRes {
    bf16* XB; float* xt; float alpha;
    __device__ __forceinline__ void operator()(int trow, int col, f32x4 v) const {
        bf16* p = XB + (size_t)(R_META + trow) * 1024 + col; const u32x2 xr = *(const u32x2*)p;
        v.x += alpha * bflo(xr.x); v.y += alpha * bfhi(xr.x); v.z += alpha * bflo(xr.y); v.w += alpha * bfhi(xr.y);
        if (xt) *(f32x4*)(xt + (size_t)trow * 1024 + col) = v; else { u32x2 o; o.x = pk2(v.x, v.y); o.y = pk2(v.z, v.w); *(u32x2*)p = o; }
    }
};
struct MiniBf16 {
    bf16* O; int ldc;
    __device__ __forceinline__ void operator()(int trow, int col, f32x4 v) const { u32x2 o; o.x = pk2(v.x, v.y); o.y = pk2(v.z, v.w); *(u32x2*)(O + (size_t)(R_META + trow) * ldc + col) = o; }
};
template <class EpiT> __device__ __forceinline__ void mini_gemm(const bf16* A, const bf16* Bt, int K, int N, LAS unsigned char* lds, const EpiT& E) {
    const int tid = opaque_tid(), lane = tid & 63, wave = __builtin_amdgcn_readfirstlane(tid >> 6), fr = lane & 15, fq = lane >> 4;
    const int npn = N / 64, npieces = 11 * npn, kw = K / 8, nks = kw / 32;
    LAS float* P = (LAS float*)lds;
    for (int pc = blockIdx.x; pc < npieces; pc += gridDim.x) {
        const int pm = pc / npn, pn = pc - pm * npn;
        const bf16* ap = A + (size_t)(R_META + 48 * pm + fr) * K + wave * kw + 8 * fq;
        const bf16* bp = Bt + (size_t)(64 * pn + fr) * K + wave * kw + 8 * fq;
        f32x4 acc[3][4];
#pragma unroll
        for (int m = 0; m < 3; ++m)
#pragma unroll
            for (int n = 0; n < 4; ++n) acc[m][n] = (f32x4){0.f, 0.f, 0.f, 0.f};
#pragma unroll 4
        for (int ks = 0; ks < nks; ++ks) {
            bf16x8 a[3], b[4];
#pragma unroll
            for (int m = 0; m < 3; ++m) a[m] = *(const bf16x8*)(ap + (size_t)(16 * m) * K + 32 * ks);
#pragma unroll
            for (int n = 0; n < 4; ++n) b[n] = *(const bf16x8*)(bp + (size_t)(16 * n) * K + 32 * ks);
#pragma unroll
            for (int m = 0; m < 3; ++m)
#pragma unroll
                for (int n = 0; n < 4; ++n) acc[m][n] = __builtin_amdgcn_mfma_f32_16x16x32_bf16(b[n], a[m], acc[m][n], 0, 0, 0);
        }
#pragma unroll
        for (int m = 0; m < 3; ++m)
#pragma unroll
            for (int n = 0; n < 4; ++n) *(LAS f32x4*)(P + (wave * 48 + 16 * m + fr) * 68 + 16 * n + 4 * fq) = acc[m][n];
        __syncthreads();
        for (int g = tid; g < 768; g += 512) {
            const int row = g >> 4, c4 = (g & 15) * 4;
            f32x4 v = *(const LAS f32x4*)(P + row * 68 + c4);
#pragma unroll
            for (int w = 1; w < 8; ++w) v += *(const LAS f32x4*)(P + (w * 48 + row) * 68 + c4);
            E(48 * pm + row, 64 * pn + c4, v);
        }
        __syncthreads();
    }
}
#define XB_TMO      128
#define XB_XCNT(j)  (256  + 64 * (j))
#define XB_XSUB(j)  (1280 + 64 * (j))
#define XB_XGEN(j)  (2304 + 64 * (j))
#define XB_TOP      3328
#define XB_TOPGEN   3392
#define XCD_BAR_WORDS 3456
#define XB_SPIN_CAP (1u << 18)

__device__ __forceinline__ unsigned xb_ld(unsigned* p)              { return __hip_atomic_load(p, __ATOMIC_RELAXED, __HIP_MEMORY_SCOPE_AGENT); }
__device__ __forceinline__ unsigned xb_add(unsigned* p, unsigned v) { return __hip_atomic_fetch_add(p, v, __ATOMIC_RELAXED, __HIP_MEMORY_SCOPE_AGENT); }
__device__ __forceinline__ unsigned xb_xcc_id() { return (unsigned)__builtin_amdgcn_s_getreg((3 << 11) | 20) & 0xFu; }
#define XB_SPIN(cond, bar) do { unsigned _sp = 0; while (cond) { __builtin_amdgcn_s_sleep(1); \
    if ((++_sp & 255u) == 0u) { if (xb_ld(&(bar)[XB_TMO])) break; if (_sp > XB_SPIN_CAP) { atomicAdd(&(bar)[XB_TMO], 1u); break; } } } } while (0)

struct XcdBarrier {
    unsigned* bar; unsigned x;
    volatile LAS unsigned* st;
};

__device__ __forceinline__ XcdBarrier xcd_barrier_post(unsigned* bar, volatile LAS unsigned* st) {
    XcdBarrier b; b.bar = bar; b.x = xb_xcc_id(); b.st = st;
    if (threadIdx.x == 0) (void)xb_add(&bar[XB_XCNT(b.x)], 1u);
    return b;
}
__device__ __forceinline__ void xcd_barrier_complete(unsigned* bar, unsigned x, unsigned& nloc, unsigned& nx) {
    const unsigned G = gridDim.x * gridDim.y * gridDim.z;
    unsigned sum, cnt, mine, sp = 0u;
    for (;;) {
        sum = 0u; cnt = 0u; mine = 0u;
#pragma unroll
        for (unsigned j = 0; j < 16; ++j) { const unsigned c = xb_ld(&bar[XB_XCNT(j)]); sum += c; cnt += (c > 0u) ? 1u : 0u; mine = (j == x) ? c : mine; }
        if (sum == G) break;
        __builtin_amdgcn_s_sleep(1);
        if ((++sp & 255u) == 0u) { if (xb_ld(&bar[XB_TMO])) break; if (sp > XB_SPIN_CAP) { atomicAdd(&bar[XB_TMO], 1u); break; } }
    }
    nloc = mine > 0u ? mine : 1u; nx = cnt > 0u ? cnt : 1u;
}

__device__ __forceinline__ void xcd_barrier(const XcdBarrier& b) {
    asm volatile("s_waitcnt vmcnt(0)" ::: "memory");
    __syncthreads();
    if (threadIdx.x == 0) {
        unsigned* bar = b.bar;
        __builtin_amdgcn_s_waitcnt(0);
        unsigned nloc = b.st[0], nx = b.st[1];
        if (nloc == 0u) { xcd_barrier_complete(bar, b.x, nloc, nx); b.st[0] = nloc; b.st[1] = nx; }
        const unsigned old = xb_add(&bar[XB_XSUB(b.x)], 1u);
        const unsigned gen = old / nloc;
        if (old + 1u == (gen + 1u) * nloc) {
            __builtin_amdgcn_fence(__ATOMIC_RELEASE, "agent");
            asm volatile("s_waitcnt vmcnt(0)" ::: "memory");
            const unsigned og = xb_add(&bar[XB_TOP], 1u);
            const unsigned tg = og / nx;
            if (og + 1u == (tg + 1u) * nx) xb_add(&bar[XB_TOPGEN], 1u);
            else XB_SPIN(xb_ld(&bar[XB_TOPGEN]) == tg, bar);
            __builtin_amdgcn_fence(__ATOMIC_ACQUIRE, "agent");
            xb_add(&bar[XB_XGEN(b.x)], 1u);
            asm volatile("s_waitcnt vmcnt(0)" ::: "memory");
        } else {
            XB_SPIN(xb_ld(&bar[XB_XGEN(b.x)]) == gen, bar);
            __builtin_amdgcn_fence(__ATOMIC_ACQUIRE, "agent");
            asm volatile("s_waitcnt vmcnt(0)" ::: "memory");
        }
    }
    __syncthreads();
}
#define GSYNC() xcd_barrier(bar)
template <int l> __device__ __forceinline__ void layer_body(const Ctx& C, const XcdBarrier& bar, LAS unsigned char* lds, unsigned char* ws, const pg8::bf16_t* XB, float* XT, const int G, const int bid) {
        {
            { MiniBf16 ME{(bf16*)(ws + WS_H), HW}; mini_gemm(XB, (const bf16*)(ws + WS_WIN), 1024, HW, lds, ME); }
            pg8::Gemm g{XB, (const pg8::bf16_t*)(ws + WS_WIN), 16384, HW, 1024}; pg8::StaticOrder S; S.init(16384, HW, G, bid);
            pg8::EpiBf16 E{(pg8::bf16_t*)(ws + WS_H), HW, 0, 0};
            pg8::gemm_phase<pg8::EpiBf16, pg8::StaticOrder, true, true>(lds, g, S, E);
        }
        GSYNC();
        for (int tile = bid; tile < 257; tile += G) mixA_tile(C, l, tile, lds, (tile == 256 || tile == 0) ? 1 : 0);
        GSYNC();
        scan_phase(C, l);
        {
            const int r = G - 1 - bid;
            if (r < 16) mixA_tile(C, l, 257 + (r >> 1), lds, 2, r & 1);
            else if (r < 18) mixA_tile(C, l, 256, lds, 2, r & 1);
            else if (r < 20) mixA_tile(C, l, 0, lds, 2, r & 1);
            else if (r == 20) glaC_tile(C, l, 256, lds);
        }
        GSYNC();
        for (int tile = bid; tile < 256; tile += G) glaC_tile(C, l, tile, lds);
        for (int j = bid; j < 256; j += G) gla_sample_item(C, l, j, lds);
        GSYNC();
        {
            { MiniRes ME{(bf16*)(ws + WS_XB), nullptr, ALPHA}; mini_gemm((const bf16*)(ws + WS_MIX), (const bf16*)(ws + WS_WOUT), 1024, 1024, lds, ME); }
            pg8::Gemm g{(const pg8::bf16_t*)(ws + WS_MIX), (const pg8::bf16_t*)(ws + WS_WOUT), 16384, 1024, 1024}; pg8::StaticOrder S; S.init(16384, 1024, G, bid);
            pg8::EpiRes E{(pg8::bf16_t*)(ws + WS_XB), nullptr, ALPHA};
            pg8::gemm_phase<pg8::EpiRes, pg8::StaticOrder, true, true>(lds, g, S, E);
        }
        GSYNC();
        ln_phase(C, CIN(13) + l * 1024, CIN(14) + l * 1024, false);
        GSYNC();
        {
            pg8::Gemm g{XB, (const pg8::bf16_t*)(ws + WS_WUG), MP, 2 * DFF, 1024}; pg8::StaticOrder S; S.init(MP, 2 * DFF, G, bid);
            pg8::EpiConv E{(pg8::bf16_t*)(ws + WS_AUP), (pg8::bf16_t*)(ws + WS_GTT), (pg8::bf16_t*)(ws + WS_GTOP), (pg8::bf16_t*)(ws + WS_GLAST), CIN(17) + (size_t)l * 3 * DFF, CIN(18) + (size_t)l * DFF};
            pg8::gemm_phase<pg8::EpiConv, pg8::StaticOrder, true, true>(lds, g, S, E);
        }
        if (l == 0) { const int rem = (67 * 22) % G; convert_weights(C, 1, lds, 1, rem, G - rem); }
        GSYNC();
        conv_phase(C, l);
        GSYNC();
        {
            { MiniRes ME{(bf16*)(ws + WS_XB), nullptr, ALPHA}; mini_gemm((const bf16*)(ws + WS_AUP), (const bf16*)(ws + WS_WDN), DFF, 1024, lds, ME); }
            pg8::Gemm g{(const pg8::bf16_t*)(ws + WS_AUP), (const pg8::bf16_t*)(ws + WS_WDN), 16384, 1024, DFF}; pg8::StaticOrder S; S.init(16384, 1024, G, bid);
            pg8::EpiRes E{(pg8::bf16_t*)(ws + WS_XB), nullptr, ALPHA};
            pg8::gemm_phase<pg8::EpiRes, pg8::StaticOrder, true, true>(lds, g, S, E);
        }
        if (l == 0) { const int w0 = G > 176 ? 176 : 0; convert_weights(C, 1, lds, 2, w0, G - w0); }
        GSYNC();
        ln_phase(C, CIN(20) + l * 1024, CIN(21) + l * 1024, l == 1);
        if (l == 0) { convert_weights(C, 1, lds, 3, 0, G); GSYNC(); }
}
#ifndef USE_COOP
#define USE_COOP 1
#endif
__global__ void __launch_bounds__(512, 2) hybrid_fwd(Args a) {
    extern __shared__ __attribute__((aligned(16))) unsigned char lds_raw[];
    LAS unsigned char* lds = (LAS unsigned char*)lds_raw;
#if USE_COOP
    cg::grid_group grid = cg::this_grid();
#endif
    Ctx C;
    C.ka = (const __attribute__((address_space(4))) Args*)__builtin_amdgcn_kernarg_segment_ptr(); C.out = a.out; C.ws = a.ws;
    const int G = gridDim.x, bid = blockIdx.x;
    unsigned char* ws = a.ws;
    const pg8::bf16_t* XB = (const pg8::bf16_t*)(ws + WS_XB);
    float* XT = (float*)(ws + WS_XTAIL);

    if (threadIdx.x < 16) ((LAS unsigned*)(lds + LDS_BYTES - 64))[threadIdx.x] = 0u;
    __syncthreads();
#if USE_COOP
    if (bid == 0) { for (int i = threadIdx.x; i < XCD_BAR_WORDS; i += 512) __hip_atomic_store((unsigned*)ws + i, 0u, __ATOMIC_RELAXED, __HIP_MEMORY_SCOPE_AGENT); }
    asm volatile("s_waitcnt vmcnt(0) lgkmcnt(0)" ::: "memory");
    grid.sync();
#endif
    XcdBarrier bar = xcd_barrier_post((unsigned*)ws, (volatile LAS unsigned*)(lds + LDS_BYTES - 64));
    convert_weights(C, 0, lds, 0, 0, G);
    build_x(C);
    GSYNC();
    layer_body<0>(C, bar, lds, ws, XB, XT, G, bid);
    layer_body<1>(C, bar, lds, ws, XB, XT, G, bid);
}

extern "C" void kernel_launch(void* const* d_in, const int* in_sizes, int n_in, void* d_out, int out_size, void* d_ws, size_t ws_size, hipStream_t stream) {
    static int grid = 0;
    if (grid == 0) {
        if (n_in != 22 || ws_size < WS_END) { fprintf(stderr, "kernel_launch: unexpected n_in %d / ws_size %zu\n", n_in, ws_size); grid = -1; return; }
        int dev = 0, cus = 0, per_cu = 0;
        hipGetDevice(&dev); hipDeviceGetAttribute(&cus, hipDeviceAttributeMultiprocessorCount, dev);
        if (hipFuncSetAttribute((const void*)hybrid_fwd, hipFuncAttributeMaxDynamicSharedMemorySize, LDS_BYTES) != hipSuccess) { fprintf(stderr, "kernel_launch: hipFuncSetAttribute failed\n"); grid = -1; return; }
        if (hipOccupancyMaxActiveBlocksPerMultiprocessor(&per_cu, (const void*)hybrid_fwd, 512, LDS_BYTES) != hipSuccess || per_cu < 1) { fprintf(stderr, "kernel_launch: occupancy query says %d blocks/CU\n", per_cu); (void)hipGetLastError(); per_cu = 1; }
        grid = cus;
        if (grid > cus * per_cu) grid = cus * per_cu;
        fprintf(stderr, "kernel_launch: grid %d (cus %d, per_cu %d)\n", grid, cus, per_cu);
    }
    if (grid < 0) return;
#if !USE_COOP
    if (hipMemsetAsync(d_ws, 0, 65536, stream) != hipSuccess) { fprintf(stderr, "kernel_launch: memset failed\n"); return; }
#endif
    Args a{};
    for (int i = 0; i < 22; ++i) a.in[i] = (const float*)d_in[i];
    a.out = (float*)d_out; a.ws = (unsigned char*)d_ws;
#if USE_COOP
    void* args[] = {&a};
    hipError_t e = hipLaunchCooperativeKernel((const void*)hybrid_fwd, dim3(grid), dim3(512), args, LDS_BYTES, stream);
    if (e != hipSuccess) fprintf(stderr, "cooperative launch failed: %s (grid %d)\n", hipGetErrorString(e), grid);
#else
    hipLaunchKernelGGL(hybrid_fwd, dim3(grid), dim3(512), LDS_BYTES, stream, a);
#endif
}
```
